# Optimizing an MI355X kernel written in HIP

```python
import math
import jax
import jax.numpy as jnp
from jax import lax
import numpy as np

D_MODEL = 1024
BATCH = 4
SEQ = 4096
DEPTH = 1

MLA_HEADS = 8
MLA_NOPE = 128
MLA_ROPE = 64
MLA_V = 128
Q_LORA = 384
KV_LORA = 256
ROPE_BASE = 10000.0
ATTN_BLOCK = 128
RET_HEADS = 8
RET_DK = 128
RET_DV = 128
RET_CHUNK = 128
N_EXPERTS = 32
TOP_K = 4
D_EXPERT = 1024
SWIGLU_LIMIT = 7.0
SWIGLU_ALPHA = 1.702
EXPERT_BLOCK = 128
MAX_POS_OFFSET = 2048
DN_ALPHA = (2.0 * DEPTH) ** 0.25
DN_BETA = (8.0 * DEPTH) ** -0.25
LN_EPS = 1e-5
RMS_EPS = 1e-6
GN_EPS = 1e-6
NEG_INF = -1e30
IN_SPLITS = (Q_LORA, KV_LORA, MLA_ROPE,
             RET_HEADS * RET_DK, RET_HEADS * RET_DK,
             RET_HEADS * RET_DV, RET_HEADS * RET_DV,
             D_MODEL, D_MODEL)
D_IN = Q_LORA + KV_LORA + MLA_ROPE + 2 * RET_HEADS * RET_DK + 2 * RET_HEADS * RET_DV + 2 * D_MODEL

kernel_name = 'hybrid_mla_retention_moe_deepnorm'


def _layernorm(x, g, b):
    xf = x.astype(jnp.float32)
    mu = jnp.mean(xf, axis=-1, keepdims=True)
    var = jnp.mean(jnp.square(xf - mu), axis=-1, keepdims=True)
    return ((xf - mu) * lax.rsqrt(var + LN_EPS) * g + b).astype(x.dtype)


def _rmsnorm(x, g):
    xf = x.astype(jnp.float32)
    return (xf * lax.rsqrt(jnp.mean(jnp.square(xf), axis=-1, keepdims=True) + RMS_EPS) * g).astype(x.dtype)


def _rotary(x, positions, inv_freq):
    ang = positions.astype(jnp.float32)[:, :, None] * inv_freq[None, None, :]
    cos = jnp.cos(ang)[:, :, None, :]
    sin = jnp.sin(ang)[:, :, None, :]
    xf = x.astype(jnp.float32)
    half = x.shape[-1] // 2
    x1, x2 = xf[..., :half], xf[..., half:]
    return jnp.concatenate([x1 * cos - x2 * sin, x2 * cos + x1 * sin], axis=-1).astype(x.dtype)


def _causal_block_attention(q, k, v):
    B, S, H, Dq = q.shape
    nq = S // ATTN_BLOCK
    scale = Dq ** -0.5
    qb = q.reshape(B, nq, ATTN_BLOCK, H, Dq).transpose(1, 0, 2, 3, 4)
    starts = jnp.arange(nq, dtype=jnp.int32) * ATTN_BLOCK
    key_pos = jnp.arange(S, dtype=jnp.int32)

    def one_block(args):
        q_blk, start = args
        s = jnp.einsum('bqhd,bkhd->bhqk', q_blk, k).astype(jnp.float32) * scale
        q_pos = start + jnp.arange(ATTN_BLOCK, dtype=jnp.int32)
        causal = (q_pos[:, None] >= key_pos[None, :])[None, None]
        p = jax.nn.softmax(jnp.where(causal, s, NEG_INF), axis=-1).astype(v.dtype)
        return jnp.einsum('bhqk,bkhd->bqhd', p, v)

    o = lax.map(one_block, (qb, starts))
    return o.transpose(1, 0, 2, 3, 4).reshape(B, S, H, v.shape[-1])


def _retention(q, k, v, positions):
    B, S, H, Dk = q.shape
    Dv = v.shape[-1]
    C = RET_CHUNK
    N = S // C
    inv_freq = 1.0 / (10000.0 ** jnp.linspace(0.0, 1.0, Dk // 2, dtype=jnp.float32))
    q = _rotary(q, positions, inv_freq)
    k = _rotary(k, positions, inv_freq) * (Dk ** -0.5)
    log_gamma = jnp.log(1.0 - 2.0 ** (-5.0 - jnp.arange(H, dtype=jnp.float32)))
    idx = jnp.arange(C, dtype=jnp.float32)
    rel = idx[:, None] - idx[None, :]
    decay = jnp.where(rel[None] >= 0,
                      jnp.exp(jnp.maximum(rel, 0.0)[None] * log_gamma[:, None, None]), 0.0)
    qc = q.reshape(B, N, C, H, Dk)
    kc = k.reshape(B, N, C, H, Dk)
    vc = v.reshape(B, N, C, H, Dv)
    scores = jnp.einsum('bnihd,bnjhd->bnhij', qc, kc).astype(jnp.float32) * decay[None, None]
    o_inner = jnp.einsum('bnhij,bnjhe->bnihe', scores, vc.astype(jnp.float32))
    k_w = jnp.exp((C - 1.0 - idx)[:, None] * log_gamma[None, :])
    q_w = jnp.exp((idx + 1.0)[:, None] * log_gamma[None, :])
    U = jnp.einsum('bnjhd,bnjhe->nbhde', kc.astype(jnp.float32) * k_w[:, :, None],
                   vc.astype(jnp.float32))
    chunk_decay = jnp.exp(C * log_gamma)[None, :, None, None]

    def step(R, U_n):
        return chunk_decay * R + U_n, R

    _, R_prev = lax.scan(step, jnp.zeros((B, H, Dk, Dv), jnp.float32), U)
    o_cross = jnp.einsum('bnihd,nbhde->bnihe', qc.astype(jnp.float32) * q_w[:, :, None], R_prev)
    o = (o_inner + o_cross).reshape(B, S, H, Dv)
    mu = jnp.mean(o, axis=-1, keepdims=True)
    var = jnp.mean(jnp.square(o - mu), axis=-1, keepdims=True)
    return ((o - mu) * lax.rsqrt(var + GN_EPS)).astype(v.dtype)


def _hybrid_mixer(x, positions, w_in, q_norm_g, w_uq, kv_norm_g, w_ukv, w_o):
    B, S, _ = x.shape
    split_at = [int(i) for i in np.cumsum(IN_SPLITS)[:-1]]
    proj = x @ w_in
    c_q, c_kv, k_r, r_q, r_k, r_v, r_g, g_mla, g_ret = jnp.split(proj, split_at, axis=-1)
    inv_freq = 1.0 / (ROPE_BASE ** (jnp.arange(0, MLA_ROPE, 2, dtype=jnp.float32) / MLA_ROPE))
    q = (_rmsnorm(c_q, q_norm_g) @ w_uq).reshape(B, S, MLA_HEADS, MLA_NOPE + MLA_ROPE)
    q = jnp.concatenate([q[..., :MLA_NOPE], _rotary(q[..., MLA_NOPE:], positions, inv_freq)], axis=-1)
    kv = (_rmsnorm(c_kv, kv_norm_g) @ w_ukv).reshape(B, S, MLA_HEADS, MLA_NOPE + MLA_V)
    k_nope, v = kv[..., :MLA_NOPE], kv[..., MLA_NOPE:]
    k_rope = _rotary(k_r[:, :, None, :], positions, inv_freq)
    k = jnp.concatenate([k_nope, jnp.broadcast_to(k_rope, (B, S, MLA_HEADS, MLA_ROPE))], axis=-1)
    o_mla = _causal_block_attention(q, k, v).reshape(B, S, MLA_HEADS * MLA_V)
    o_ret = _retention(r_q.reshape(B, S, RET_HEADS, RET_DK), r_k.reshape(B, S, RET_HEADS, RET_DK),
                       r_v.reshape(B, S, RET_HEADS, RET_DV), positions)
    o_ret = o_ret.reshape(B, S, RET_HEADS * RET_DV) * jax.nn.silu(r_g)
    mixed = jax.nn.sigmoid(g_mla) * o_mla + jax.nn.sigmoid(g_ret) * o_ret
    return (mixed @ w_o).astype(x.dtype)


def _routed_experts(h, w_router, b_router, w_up, b_up, w_down, b_down):
    Bn, Sn, D = h.shape
    T = Bn * Sn
    xt = h.reshape(T, D)
    logits = (xt @ w_router + b_router).astype(jnp.float32)
    top_v, top_i = lax.top_k(logits, TOP_K)
    gate = jax.nn.softmax(top_v, axis=-1)
    n_assign = T * TOP_K
    flat_e = top_i.reshape(-1).astype(jnp.int32)
    flat_tok = jnp.arange(n_assign, dtype=jnp.int32) // TOP_K
    flat_w = gate.reshape(-1)
    order = jnp.argsort(flat_e)
    se = flat_e[order]
    counts = jnp.bincount(flat_e, length=N_EXPERTS).astype(jnp.int32)
    padded = ((counts + EXPERT_BLOCK - 1) // EXPERT_BLOCK) * EXPERT_BLOCK
    pad_end = jnp.cumsum(padded)
    pad_start = pad_end - padded
    grp_start = jnp.cumsum(counts) - counts
    rank = jnp.arange(n_assign, dtype=jnp.int32) - grp_start[se]
    dest = pad_start[se] + rank
    P = n_assign + N_EXPERTS * EXPERT_BLOCK
    n_blocks = P // EXPERT_BLOCK
    row_tok = jnp.zeros((P,), jnp.int32).at[dest].set(flat_tok[order])
    row_w = jnp.zeros((P,), jnp.float32).at[dest].set(flat_w[order])
    row_valid = jnp.zeros((P,), bool).at[dest].set(True)
    blk_e = jnp.minimum(jnp.searchsorted(pad_end, jnp.arange(n_blocks, dtype=jnp.int32) * EXPERT_BLOCK,
                                         side='right'), N_EXPERTS - 1).astype(jnp.int32)
    xs = xt[row_tok].reshape(n_blocks, EXPERT_BLOCK, D)

    def expert_block(args):
        xb, e = args
        hcat = xb @ w_up[e] + b_up[e]
        h_glu = jnp.minimum(hcat[:, :D_EXPERT], SWIGLU_LIMIT)
        h_lin = jnp.clip(hcat[:, D_EXPERT:], -SWIGLU_LIMIT, SWIGLU_LIMIT)
        a = h_glu * jax.nn.sigmoid(SWIGLU_ALPHA * h_glu) * (h_lin + 1.0)
        return a @ w_down[e] + b_down[e]

    ys = lax.map(expert_block, (xs, blk_e)).reshape(P, D)
    ys = jnp.where(row_valid[:, None], ys * row_w[:, None], 0.0)
    out = jax.ops.segment_sum(ys, row_tok, num_segments=T)
    return out.reshape(Bn, Sn, D).astype(h.dtype)


def setup_inputs(seed: int = 0) -> dict:
    key = jax.random.key(seed)
    ks = jax.random.split(key, 20)
    f32 = jnp.float32

    def nrm(k, shape, scale):
        return jax.random.normal(k, shape, f32) * scale

    x = nrm(ks[0], (BATCH, SEQ, D_MODEL), 1.0)
    offset = jax.random.randint(ks[1], (BATCH, 1), 0, MAX_POS_OFFSET, dtype=jnp.int32)
    positions = offset + jnp.arange(SEQ, dtype=jnp.int32)[None, :]
    return {
        'x': x,
        'positions': positions,
        'w_in': nrm(ks[2], (DEPTH, D_MODEL, D_IN), D_MODEL ** -0.5),
        'q_norm_g': 1.0 + nrm(ks[3], (DEPTH, Q_LORA), 0.02),
        'w_uq': nrm(ks[4], (DEPTH, Q_LORA, MLA_HEADS * (MLA_NOPE + MLA_ROPE)), Q_LORA ** -0.5),
        'kv_norm_g': 1.0 + nrm(ks[5], (DEPTH, KV_LORA), 0.02),
        'w_ukv': nrm(ks[6], (DEPTH, KV_LORA, MLA_HEADS * (MLA_NOPE + MLA_V)), KV_LORA ** -0.5),
        'w_o': nrm(ks[7], (DEPTH, D_MODEL, D_MODEL), D_MODEL ** -0.5 * DN_BETA),
        'ln1_g': 1.0 + nrm(ks[8], (DEPTH, D_MODEL), 0.02),
        'ln1_b': nrm(ks[9], (DEPTH, D_MODEL), 0.02),
        'w_router': nrm(ks[10], (DEPTH, D_MODEL, N_EXPERTS), D_MODEL ** -0.5),
        'b_router': nrm(ks[11], (DEPTH, N_EXPERTS), 0.01),
        'w_up': nrm(ks[12], (DEPTH, N_EXPERTS, D_MODEL, 2 * D_EXPERT), D_MODEL ** -0.5),
        'b_up': nrm(ks[13], (DEPTH, N_EXPERTS, 2 * D_EXPERT), 0.01),
        'w_down': nrm(ks[14], (DEPTH, N_EXPERTS, D_EXPERT, D_MODEL), D_EXPERT ** -0.5 * DN_BETA),
        'b_down': nrm(ks[15], (DEPTH, N_EXPERTS, D_MODEL), 0.01),
        'ln2_g': 1.0 + nrm(ks[16], (DEPTH, D_MODEL), 0.02),
        'ln2_b': nrm(ks[17], (DEPTH, D_MODEL), 0.02),
    }


def reference(x, positions, w_in, q_norm_g, w_uq, kv_norm_g, w_ukv, w_o, ln1_g, ln1_b,
              w_router, b_router, w_up, b_up, w_down, b_down, ln2_g, ln2_b):
    h = x
    for l in range(DEPTH):
        mix = _hybrid_mixer(h, positions, w_in[l], q_norm_g[l], w_uq[l], kv_norm_g[l], w_ukv[l], w_o[l])
        h = _layernorm(DN_ALPHA * h + mix, ln1_g[l], ln1_b[l])
        ffn = _routed_experts(h, w_router[l], b_router[l], w_up[l], b_up[l], w_down[l], b_down[l])
        h = _layernorm(DN_ALPHA * h + ffn, ln2_g[l], ln2_b[l])
    return h
```

```cpp
#include <hip/hip_runtime.h>
#include <cstdio>
#include <cstdint>
#define LAS __attribute__((address_space(3)))
namespace pg8 {
#define PG8_LAS __attribute__((address_space(3)))
typedef unsigned short bf16_t;
typedef short bf16x8 __attribute__((ext_vector_type(8)));
typedef float f32x4 __attribute__((ext_vector_type(4)));
typedef unsigned u32x4 __attribute__((ext_vector_type(4)));
typedef int i32x4 __attribute__((ext_vector_type(4)));
typedef int i32x8 __attribute__((ext_vector_type(8)));
constexpr int BM = 256, BK = 64, HALF = 128, HTB = HALF * BK * 2  , STAGE_BYTES = 8 * HTB, NXCD = 8, WGM = 4;

__host__ __device__ __forceinline__ int lds_byte(int r, int c) { const int st = (r >> 4) * 2 + (c >> 5), rr = r & 15, cc = c & 31, ob = rr * 64 + cc * 2; return st * 1024 + (ob ^ (((ob >> 9) & 1) << 5)); }
__host__ __device__ __forceinline__ void stage_rc(int b, int& R, int& C) { const int st = b / 1024, sb = b % 1024, swz = sb ^ (((sb >> 9) & 1) << 5); R = (st >> 1) * 16 + swz / 64; C = (st & 1) * 32 + (swz % 64) / 2; }
__host__ __device__ __forceinline__ int perm32(int rho) { const int n = rho >> 4, i = rho & 15; return 8 * (i >> 2) + 4 * n + (i & 3); }

struct Unit { int pm, pn, pb, e; };
struct Gemm { const bf16_t* A; const bf16_t* Bt; int M, N, K; };

struct StaticOrder {
    int nM, nN, nwg, G, c;
    __host__ __device__ void init(int M, int N, int G_, int c_) { nM = M / BM; nN = N / BM; nwg = nM * nN; G = G_; c = c_; }
    __host__ __device__ __forceinline__ bool next(int i, Unit& u) const {
        const long L = (long)i * G + c; if (L >= nwg) return false;
        int wgid = (int)L; { const int q = nwg / NXCD, r = nwg % NXCD, xcd = wgid % NXCD, off = wgid / NXCD; wgid = (xcd < r ? xcd * (q + 1) : r * (q + 1) + (xcd - r) * q) + off; }
        const int nig = WGM * nN, gid = wgid / nig, fm = gid * WGM, gsz = (nM - fm) < WGM ? (nM - fm) : WGM;
        u.pm = fm + ((wgid % nig) % gsz); u.pn = (wgid % nig) / gsz; u.pb = u.pn; u.e = 0; return true;
    }
    __device__ __forceinline__ void a_ready(const Unit&) const {}
    __device__ __forceinline__ void done(const Unit&) const {}
};

struct GroupedOrder : StaticOrder {
    const int* tile_e;
    __device__ __forceinline__ bool next(int i, Unit& u) const {
        if (!StaticOrder::next(i, u)) return false;
        u.e = __builtin_amdgcn_readfirstlane(tile_e[u.pm]); u.pb = u.e * nN + u.pn; return true;
    }
};

typedef unsigned u32x2 __attribute__((ext_vector_type(2)));
typedef float f32x2_t __attribute__((ext_vector_type(2))); typedef __bf16 bf16x2_t __attribute__((ext_vector_type(2)));
__device__ __forceinline__ unsigned cvt_pk_bf16(float lo, float hi) { const f32x2_t v = {lo, hi}; const bf16x2_t b = __builtin_convertvector(v, bf16x2_t); return __builtin_bit_cast(unsigned, b); }
__device__ __forceinline__ u32x4 pack8(const f32x4 a, const f32x4 b) { u32x4 w; w.x = cvt_pk_bf16(a[0], a[1]); w.y = cvt_pk_bf16(a[2], a[3]); w.z = cvt_pk_bf16(b[0], b[1]); w.w = cvt_pk_bf16(b[2], b[3]); return w; }
__device__ __forceinline__ unsigned pack4_fp8(float a, float b, float c, float d) { int w = 0; w = __builtin_amdgcn_cvt_pk_fp8_f32(a, b, w, false); w = __builtin_amdgcn_cvt_pk_fp8_f32(c, d, w, true); return (unsigned)w; }
__device__ __forceinline__ float sigm(float x) { return __builtin_amdgcn_rcpf(1.0f + __expf(-x)); }
__device__ __forceinline__ f32x4 sigm4(const f32x4 x) { f32x4 e = x * -1.4426950408889634f;
#pragma unroll
    for (int j = 0; j < 4; ++j) e[j] = __builtin_amdgcn_exp2f(e[j]);
    e = e + 1.0f;
#pragma unroll
    for (int j = 0; j < 4; ++j) e[j] = __builtin_amdgcn_rcpf(e[j]);
    return e; }

#define EPI_PIN4(a, b, c, d) asm volatile("" : "+v"(a), "+v"(b), "+v"(c), "+v"(d) :: "memory")
struct EpiProj {
    static constexpr bool PERM = true, AFTER_DRAIN = false, HAS_INIT = false;
    bf16_t *CQ, *CKV, *KR, *RQ, *RK, *RV, *GR, *GM; float *ssq_q, *ssq_kv;
    const float *cosM, *sinM, *cosR, *sinR;
    __device__ __forceinline__ void operator()(const f32x4 (&acc)[2][2][4][2], const Unit& u, int wr, int wc, int fr, int fq) const {
        asm volatile("" : "+v"(fr), "+v"(fq));
        const int pn = u.pn, row0 = u.pm * BM + wr * 64 + fr, c8 = wc * 32 + 8 * fq;
        if (pn <= 1) {
            bf16_t* O = pn == 0 ? CQ : CKV; const int ld = pn == 0 ? 384 : 256; float* ssq = pn == 0 ? ssq_q + wc : ssq_kv + wc; const int sst = pn == 0 ? 8 : 4;
#pragma unroll
            for (int ai = 0; ai < 2; ++ai)
#pragma unroll
                for (int m = 0; m < 4; ++m) { const int row = row0 + ai * HALF + m * 16; float s = 0.f;
#pragma unroll
                    for (int bj = 0; bj < 2; ++bj) { const f32x4 v0 = acc[ai][bj][m][0], v1 = acc[ai][bj][m][1];
                        s += (v0[0] * v0[0] + v0[1] * v0[1]) + (v0[2] * v0[2] + v0[3] * v0[3]) + (v1[0] * v1[0] + v1[1] * v1[1]) + (v1[2] * v1[2] + v1[3] * v1[3]);
                        *(u32x4*)(O + (size_t)row * ld + bj * HALF + c8) = pack8(v0, v1); }
                    s += __shfl_xor(s, 16); s += __shfl_xor(s, 32);
                    if (fq == 0) ssq[(size_t)row * sst] = s; }
        } else if (pn == 2) {
            if (wc < 2) {
#pragma unroll
                for (int ai = 0; ai < 2; ++ai)
#pragma unroll
                    for (int m = 0; m < 4; ++m) { const int row = row0 + ai * HALF + m * 16; float s = 0.f;
#pragma unroll
                        for (int bj = 0; bj < 2; ++bj) { const f32x4 v0 = acc[ai][bj][m][0], v1 = acc[ai][bj][m][1];
                            s += (v0[0] * v0[0] + v0[1] * v0[1]) + (v0[2] * v0[2] + v0[3] * v0[3]) + (v1[0] * v1[0] + v1[1] * v1[1]) + (v1[2] * v1[2] + v1[3] * v1[3]);
                            *(u32x4*)(CQ + (size_t)row * 384 + 256 + bj * 64 + c8) = pack8(v0, v1); }
                        s += __shfl_xor(s, 16); s += __shfl_xor(s, 32);
                        if (fq == 0) ssq_q[(size_t)row * 8 + 4 + wc] = s; }
            } else if (wc == 2) {
                const int f0 = 8 * fq;
#pragma unroll
                for (int ai = 0; ai < 2; ++ai)
#pragma unroll
                    for (int m = 0; m < 4; ++m) { const int row = row0 + ai * HALF + m * 16;
                        const f32x4 c0 = *(const f32x4*)(cosM + (size_t)row * 32 + f0), c1 = *(const f32x4*)(cosM + (size_t)row * 32 + f0 + 4);
                        const f32x4 s0 = *(const f32x4*)(sinM + (size_t)row * 32 + f0), s1 = *(const f32x4*)(sinM + (size_t)row * 32 + f0 + 4);
                        f32x4 a0 = acc[ai][0][m][0], a1 = acc[ai][0][m][1], b0 = acc[ai][1][m][0], b1 = acc[ai][1][m][1]; EPI_PIN4(a0, a1, b0, b1);
                        *(u32x4*)(KR + (size_t)row * 64 + f0) = pack8(a0 * c0 - b0 * s0, a1 * c1 - b1 * s1);
                        *(u32x4*)(KR + (size_t)row * 64 + 32 + f0) = pack8(b0 * c0 + a0 * s0, b1 * c1 + a1 * s1); }
            }
        } else if (pn <= 10) {
            const bool isk = pn >= 7; bf16_t* O = isk ? RK : RQ; const float sc = isk ? 0.08838834764831845f : 1.0f;
            const int head = 2 * (pn - (isk ? 7 : 3)) + (wc >> 1), f0 = 32 * (wc & 1) + 8 * fq;
            f32x4 tc[2][2], ts[2][2];
            { const size_t o = (size_t)row0 * 64 + f0; tc[0][0] = *(const f32x4*)(cosR + o); tc[0][1] = *(const f32x4*)(cosR + o + 4); ts[0][0] = *(const f32x4*)(sinR + o); ts[0][1] = *(const f32x4*)(sinR + o + 4); }
#pragma unroll
            for (int g = 0; g < 8; ++g) { const int row = row0 + (g >> 2) * HALF + (g & 3) * 16, ai = g >> 2, m = g & 3, cu = g & 1, nx = cu ^ 1;
                if (g < 7) { const size_t o = (size_t)(row0 + ((g + 1) >> 2) * HALF + ((g + 1) & 3) * 16) * 64 + f0;
                    tc[nx][0] = *(const f32x4*)(cosR + o); tc[nx][1] = *(const f32x4*)(cosR + o + 4); ts[nx][0] = *(const f32x4*)(sinR + o); ts[nx][1] = *(const f32x4*)(sinR + o + 4); }
                const f32x4 c0 = tc[cu][0] * sc, c1 = tc[cu][1] * sc, s0 = ts[cu][0] * sc, s1 = ts[cu][1] * sc;
                f32x4 a0 = acc[ai][0][m][0], a1 = acc[ai][0][m][1], b0 = acc[ai][1][m][0], b1 = acc[ai][1][m][1]; EPI_PIN4(a0, a1, b0, b1);
                *(u32x4*)(O + (size_t)row * 1024 + head * 128 + f0) = pack8(a0 * c0 - b0 * s0, a1 * c1 - b1 * s1);
                *(u32x4*)(O + (size_t)row * 1024 + head * 128 + 64 + f0) = pack8(b0 * c0 + a0 * s0, b1 * c1 + a1 * s1); }
        } else if (pn <= 14) {
            const int cb = 256 * (pn - 11) + c8;
#pragma unroll
            for (int ai = 0; ai < 2; ++ai)
#pragma unroll
                for (int m = 0; m < 4; ++m) { const int row = row0 + ai * HALF + m * 16;
#pragma unroll
                    for (int bj = 0; bj < 2; ++bj) *(u32x4*)(RV + (size_t)row * 1024 + cb + bj * HALF) = pack8(acc[ai][bj][m][0], acc[ai][bj][m][1]); }
        } else if (pn <= 22) {
            const int cb = 128 * (pn - 15) + c8;
#pragma unroll
            for (int ai = 0; ai < 2; ++ai)
#pragma unroll
                for (int m = 0; m < 4; ++m) { const int row = row0 + ai * HALF + m * 16;
                    f32x4 g0 = acc[ai][0][m][0], g1 = acc[ai][0][m][1], t0 = acc[ai][1][m][0], t1 = acc[ai][1][m][1]; EPI_PIN4(g0, g1, t0, t1);
                    f32x4 eg0 = g0 * -1.4426950408889634f, eg1 = g1 * -1.4426950408889634f, et0 = t0 * -1.4426950408889634f, et1 = t1 * -1.4426950408889634f;
#pragma unroll
                    for (int j = 0; j < 4; ++j) { eg0[j] = __builtin_amdgcn_exp2f(eg0[j]); eg1[j] = __builtin_amdgcn_exp2f(eg1[j]); et0[j] = __builtin_amdgcn_exp2f(et0[j]); et1[j] = __builtin_amdgcn_exp2f(et1[j]); }
                    f32x4 d0 = (eg0 + 1.0f) * (et0 + 1.0f), d1 = (eg1 + 1.0f) * (et1 + 1.0f);
#pragma unroll
                    for (int j = 0; j < 4; ++j) { d0[j] = __builtin_amdgcn_rcpf(d0[j]); d1[j] = __builtin_amdgcn_rcpf(d1[j]); }
                    *(u32x4*)(GR + (size_t)row * 1024 + cb) = pack8(g0 * d0, g1 * d1); }
        } else {
            const int cb = 256 * (pn - 23) + c8;
#pragma unroll
            for (int ai = 0; ai < 2; ++ai)
#pragma unroll
                for (int m = 0; m < 4; ++m) { const int row = row0 + ai * HALF + m * 16;
#pragma unroll
                    for (int bj = 0; bj < 2; ++bj) *(u32x4*)(GM + (size_t)row * 1024 + cb + bj * HALF) = pack8(sigm4(acc[ai][bj][m][0]), sigm4(acc[ai][bj][m][1]));
                    }
        }
    }
};

struct EpiQn {
    static constexpr bool PERM = true, AFTER_DRAIN = false, HAS_INIT = false;
    bf16_t* Q; const float* ssq;
    __device__ __forceinline__ void operator()(const f32x4 (&acc)[2][2][4][2], const Unit& u, int wr, int wc, int fr, int fq) const {
        asm volatile("" : "+v"(fr), "+v"(fq));
        const int pn = u.pn, row0 = u.pm * BM + wr * 64 + fr, c8 = wc * 32 + 8 * fq;
        float rsv[8];
#pragma unroll
        for (int g = 0; g < 8; ++g) { const int row = row0 + (g >> 2) * HALF + (g & 3) * 16;
            const f32x4 sA = *(const f32x4*)(ssq + (size_t)row * 8); const float sB = ssq[(size_t)row * 8 + 4], sC = ssq[(size_t)row * 8 + 5];
            rsv[g] = __builtin_amdgcn_rsqf((((sA[0] + sA[1]) + (sA[2] + sA[3])) + (sB + sC)) * (1.0f / 384.0f) + 1e-6f); }
        asm volatile("" ::: "memory");
#pragma unroll
        for (int ai = 0; ai < 2; ++ai)
#pragma unroll
            for (int m = 0; m < 4; ++m) { const int row = row0 + ai * HALF + m * 16; const float rs = rsv[ai * 4 + m];
#pragma unroll
                for (int bj = 0; bj < 2; ++bj) *(u32x4*)(Q + (size_t)row * 1536 + (2 * pn + bj) * 192 + c8) = pack8(acc[ai][bj][m][0] * rs, acc[ai][bj][m][1] * rs); }
    }
};
struct EpiQr {
    static constexpr bool PERM = true, AFTER_DRAIN = false, HAS_INIT = false;
    bf16_t* Q; const float* ssq; const float *cosM, *sinM;
    __device__ __forceinline__ void operator()(const f32x4 (&acc)[2][2][4][2], const Unit& u, int wr, int wc, int fr, int fq) const {
        asm volatile("" : "+v"(fr), "+v"(fq));
        const int row0 = u.pm * BM + wr * 64 + fr, head = 4 * u.pn + wc, f0 = 8 * fq;
        f32x4 tc[2][2], ts[2][2], sq[2]; float sq2[2][2];
#define QR_LOAD(slot, rw) do { const size_t o = (size_t)(rw) * 32 + f0; tc[slot][0] = *(const f32x4*)(cosM + o); tc[slot][1] = *(const f32x4*)(cosM + o + 4); ts[slot][0] = *(const f32x4*)(sinM + o); ts[slot][1] = *(const f32x4*)(sinM + o + 4); \
            sq[slot] = *(const f32x4*)(ssq + (size_t)(rw) * 8); sq2[slot][0] = ssq[(size_t)(rw) * 8 + 4]; sq2[slot][1] = ssq[(size_t)(rw) * 8 + 5]; } while (0)
        QR_LOAD(0, row0);
#pragma unroll
        for (int g = 0; g < 8; ++g) { const int row = row0 + (g >> 2) * HALF + (g & 3) * 16, ai = g >> 2, m = g & 3, cu = g & 1, nx = cu ^ 1;
            if (g < 7) QR_LOAD(nx, row0 + ((g + 1) >> 2) * HALF + ((g + 1) & 3) * 16);
            f32x4 a0 = acc[ai][0][m][0], a1 = acc[ai][0][m][1], b0 = acc[ai][1][m][0], b1 = acc[ai][1][m][1]; EPI_PIN4(a0, a1, b0, b1);
            const float rs = __builtin_amdgcn_rsqf((((sq[cu][0] + sq[cu][1]) + (sq[cu][2] + sq[cu][3])) + (sq2[cu][0] + sq2[cu][1])) * (1.0f / 384.0f) + 1e-6f);
            const f32x4 c0 = tc[cu][0] * rs, c1 = tc[cu][1] * rs, s0 = ts[cu][0] * rs, s1 = ts[cu][1] * rs;
            *(u32x4*)(Q + (size_t)row * 1536 + head * 192 + 128 + f0) = pack8(a0 * c0 - b0 * s0, a1 * c1 - b1 * s1);
            *(u32x4*)(Q + (size_t)row * 1536 + head * 192 + 160 + f0) = pack8(b0 * c0 + a0 * s0, b1 * c1 + a1 * s1); }
#undef QR_LOAD
    }
};
struct EpiQ {
    static constexpr bool PERM = true, AFTER_DRAIN = false, HAS_INIT = false;
    EpiQn n; EpiQr r;
    __device__ __forceinline__ void operator()(const f32x4 (&acc)[2][2][4][2], const Unit& u, int wr, int wc, int fr, int fq) const {
        if (u.pn < 4) n(acc, u, wr, wc, fr, fq); else { Unit v = u; v.pn = u.pn - 4; r(acc, v, wr, wc, fr, fq); }
    }
};
struct EpiKV {
    static constexpr bool PERM = true, AFTER_DRAIN = false, HAS_INIT = false;
    bf16_t *KN, *V; const float* ssq;
    __device__ __forceinline__ void operator()(const f32x4 (&acc)[2][2][4][2], const Unit& u, int wr, int wc, int fr, int fq) const {
        asm volatile("" : "+v"(fr), "+v"(fq));
        const int row0 = u.pm * BM + wr * 64 + fr, cb = u.pn * 128 + wc * 32 + 8 * fq;
        float rsv[8];
#pragma unroll
        for (int g = 0; g < 8; ++g) { const f32x4 sA = *(const f32x4*)(ssq + (size_t)(row0 + (g >> 2) * HALF + (g & 3) * 16) * 4);
            rsv[g] = __builtin_amdgcn_rsqf(((sA[0] + sA[1]) + (sA[2] + sA[3])) * (1.0f / 256.0f) + 1e-6f); }
        asm volatile("" ::: "memory");
#pragma unroll
        for (int ai = 0; ai < 2; ++ai)
#pragma unroll
            for (int m = 0; m < 4; ++m) { const int row = row0 + ai * HALF + m * 16; const float rs = rsv[ai * 4 + m];
                *(u32x4*)(KN + (size_t)row * 1024 + cb) = pack8(acc[ai][0][m][0] * rs, acc[ai][0][m][1] * rs);
                *(u32x4*)(V + (size_t)row * 1024 + cb) = pack8(acc[ai][1][m][0] * rs, acc[ai][1][m][1] * rs); }
    }
};
struct EpiY {
    static constexpr bool PERM = true, AFTER_DRAIN = false, HAS_INIT = false;
    const float* X; bf16_t* Y; float alpha;
    __device__ __forceinline__ void operator()(const f32x4 (&acc)[2][2][4][2], const Unit& u, int wr, int wc, int fr, int fq) const {
        asm volatile("" : "+v"(fr), "+v"(fq));
        const int row0 = u.pm * BM + wr * 64 + fr, col0 = u.pn * BM + wc * 32 + 8 * fq;
        f32x4 xv[2][2][2];
#define EPIY_LOAD(slot, g_) do { const size_t o_ = (size_t)(row0 + ((g_) >> 2) * HALF + ((g_) & 3) * 16) * 1024 + col0; \
        _Pragma("unroll") for (int bj = 0; bj < 2; ++bj) _Pragma("unroll") for (int n = 0; n < 2; ++n) xv[slot][bj][n] = __builtin_nontemporal_load((const f32x4*)(X + o_ + bj * HALF + n * 4)); } while (0)
        EPIY_LOAD(0, 0);
#pragma unroll
        for (int g = 0; g < 8; ++g) { const int ai = g >> 2, m = g & 3, cu = g & 1; const size_t off = (size_t)(row0 + ai * HALF + m * 16) * 1024 + col0;
            if (g < 7) EPIY_LOAD(cu ^ 1, g + 1);
            f32x4 a0 = acc[ai][0][m][0], a1 = acc[ai][0][m][1], b0 = acc[ai][1][m][0], b1 = acc[ai][1][m][1]; EPI_PIN4(a0, a1, b0, b1);
            *(u32x4*)(Y + off) = pack8(xv[cu][0][0] * alpha + a0, xv[cu][0][1] * alpha + a1);
            *(u32x4*)(Y + off + HALF) = pack8(xv[cu][1][0] * alpha + b0, xv[cu][1][1] * alpha + b1); }
#undef EPIY_LOAD
    }
};
struct EpiSwiglu {
    static constexpr bool PERM = true, AFTER_DRAIN = false, HAS_INIT = true; static constexpr int SCW = 122;
    unsigned char* A2; const float* b_up;
    __device__ __forceinline__ void load_init(f32x4 (&ini)[2][2], const Unit& u, int wc, int fq) const {
        const float* bg = b_up + (size_t)u.e * 2048 + u.pn * 128 + wc * 32 + 8 * fq;
        ini[0][0] = *(const f32x4*)bg; ini[0][1] = *(const f32x4*)(bg + 4); ini[1][0] = *(const f32x4*)(bg + 1024) + 1.0f; ini[1][1] = *(const f32x4*)(bg + 1028) + 1.0f;
    }
    __device__ __forceinline__ void operator()(const f32x4 (&acc)[2][2][4][2], const Unit& u, int wr, int wc, int fr, int fq) const {
        asm volatile("" : "+v"(fr), "+v"(fq));
        const int row0 = u.pm * BM + wr * 64 + fr, cb = u.pn * 128 + wc * 32 + 8 * fq;
#pragma unroll
        for (int ai = 0; ai < 2; ++ai)
#pragma unroll
            for (int m = 0; m < 4; ++m) { const int row = row0 + ai * HALF + m * 16;
                f32x4 g0 = acc[ai][0][m][0], g1 = acc[ai][0][m][1], l0 = acc[ai][1][m][0], l1 = acc[ai][1][m][1]; EPI_PIN4(g0, g1, l0, l1);
#pragma unroll
                for (int j = 0; j < 4; ++j) { g0[j] = __builtin_amdgcn_fmed3f(g0[j], -3.0e38f, 7.0f); g1[j] = __builtin_amdgcn_fmed3f(g1[j], -3.0e38f, 7.0f);
                    l0[j] = __builtin_amdgcn_fmed3f(l0[j], -6.0f, 8.0f); l1[j] = __builtin_amdgcn_fmed3f(l1[j], -6.0f, 8.0f); }
                const f32x4 t0 = g0 * -2.4554669595930156f, t1 = g1 * -2.4554669595930156f;
                f32x4 d0, d1;
#pragma unroll
                for (int j = 0; j < 4; ++j) { d0[j] = __builtin_amdgcn_exp2f(t0[j]); d1[j] = __builtin_amdgcn_exp2f(t1[j]); }
                d0 = d0 + 1.0f; d1 = d1 + 1.0f;
                f32x4 r0, r1;
#pragma unroll
                for (int j = 0; j < 4; ++j) { r0[j] = __builtin_amdgcn_rcpf(d0[j]); r1[j] = __builtin_amdgcn_rcpf(d1[j]); }
                const f32x4 o0 = (g0 * l0) * r0, o1 = (g1 * l1) * r1;
                u32x2 w; w.x = pack4_fp8(o0[0], o0[1], o0[2], o0[3]); w.y = pack4_fp8(o1[0], o1[1], o1[2], o1[3]);
                *(u32x2*)(A2 + (size_t)row * 1024 + cb) = w; }
    }
};
struct EpiDown {
    static constexpr bool PERM = true, AFTER_DRAIN = false, HAS_INIT = true; static constexpr int SCW = 126;
    unsigned char* YS; const float* b_down;
    __device__ __forceinline__ void load_init(f32x4 (&ini)[2][2], const Unit& u, int wc, int fq) const {
        const float* bb = b_down + (size_t)u.e * 1024 + u.pn * BM + wc * 32 + 8 * fq;
#pragma unroll
        for (int bj = 0; bj < 2; ++bj) { ini[bj][0] = *(const f32x4*)(bb + bj * HALF) * 16.0f; ini[bj][1] = *(const f32x4*)(bb + bj * HALF + 4) * 16.0f; }
    }
    __device__ __forceinline__ void operator()(const f32x4 (&acc)[2][2][4][2], const Unit& u, int wr, int wc, int fr, int fq) const {
        asm volatile("" : "+v"(fr), "+v"(fq));
        const int row0 = u.pm * BM + wr * 64 + fr, cb = u.pn * BM + wc * 32 + 8 * fq;
#pragma unroll
        for (int ai = 0; ai < 2; ++ai)
#pragma unroll
            for (int m = 0; m < 4; ++m) { const int row = row0 + ai * HALF + m * 16;
#pragma unroll
                for (int bj = 0; bj < 2; ++bj) { const f32x4 a = acc[ai][bj][m][0], b = acc[ai][bj][m][1];
                    u32x2 w; w.x = pack4_fp8(a[0], a[1], a[2], a[3]); w.y = pack4_fp8(b[0], b[1], b[2], b[3]);
                    *(u32x2*)(YS + (size_t)row * 1024 + cb + bj * HALF) = w; } }
    }
};
template <class Epi, class Sched, bool ALIGN_EPI = false, bool SP2 = false, bool FP8 = false, bool GATHER = false>
__device__ __forceinline__ void gemm_phase(PG8_LAS unsigned char* lds, const Gemm g, const Sched& S, const Epi& E, const PG8_LAS int* tokl = nullptr) {
    static_assert(!GATHER || SP2, "GATHER is implemented for the SP2 loop");
    int tid_ = threadIdx.x; asm volatile("" : "+v"(tid_));
    const int tid = tid_, wid = __builtin_amdgcn_readfirstlane(tid >> 6), lane = tid & 63, wr = wid >> 2, wc = wid & 3, fr = lane & 15, fq = lane >> 4;
    const int K = g.K, nt = K / BK;
    unsigned voffA, voffB;
    { int R, C; stage_rc(tid * 16, R, C); const int Rb = Epi::PERM ? ((R & ~31) + perm32(R & 31)) : R;
        voffA = (unsigned)(R * K + C) * 2u; voffB = (unsigned)(Rb * K + C) * 2u; }
    const size_t rstep = (size_t)64 * K * 2;
    unsigned gA[2][2], gN[2][2];
    int gR = 0; unsigned gC = 0; if constexpr (GATHER) { int R, C; stage_rc(tid * 16, R, C); gR = R; gC = (unsigned)C * 2u; }
#define PG8_GLOAD(dst, ui_) do { _Pragma("unroll") for (int h_ = 0; h_ < 2; ++h_) _Pragma("unroll") for (int i_ = 0; i_ < 2; ++i_) dst[h_][i_] = (unsigned)tokl[(ui_) * 256 + 128 * h_ + 64 * i_ + gR] * (unsigned)(K * 2) + gC; } while (0)
#define PG8_STA(b, h, ptr, kb, nf) do { if constexpr (GATHER) { _Pragma("unroll") for (int _i = 0; _i < 2; ++_i) \
        __builtin_amdgcn_global_load_lds((const unsigned*)((const char*)g.A + (kb) + ((nf) ? gN[h][_i] : gA[h][_i])), (PG8_LAS unsigned*)(lds + PG8_SA(b, h) + ldsw + _i * 8192), 16, 0, 0); } \
        else { PG8_STAGE(PG8_SA(b, h), ptr, voffA); } } while (0)
    const size_t kstep = (size_t)(BK * 2);
    const size_t hstep = (size_t)HALF * K * 2;
    const size_t tstep = 2 * hstep;
    const unsigned ldsw = (unsigned)wid * 1024u;
    const int aoff = lds_byte(wr * 64 + fr, fq * 8), boff = lds_byte(wc * 32 + fr, fq * 8);
#define PG8_SA(b, h) (((b) * 2 + (h)) * HTB)
#define PG8_SB(b, h) ((4 + (b) * 2 + (h)) * HTB)
#define PG8_STAGE(bufoff, gbase, voff) do { _Pragma("unroll") for (int _i = 0; _i < 2; ++_i) \
        __builtin_amdgcn_global_load_lds((const unsigned*)((const char*)(gbase) + _i * rstep + (voff)), (PG8_LAS unsigned*)(lds + (bufoff) + ldsw + _i * 8192), 16, 0, 0); } while (0)
#define PG8_LDA(dst, b, h) do { if constexpr (FP8) { _Pragma("unroll") for (int m = 0; m < 4; ++m) dst##8[m] = __builtin_shufflevector(*(const PG8_LAS i32x4*)(lds + PG8_SA(b, h) + aoff + m * 2048), *(const PG8_LAS i32x4*)(lds + PG8_SA(b, h) + aoff + m * 2048 + 1024), 0, 1, 2, 3, 4, 5, 6, 7); } \
        else { _Pragma("unroll") for (int m = 0; m < 4; ++m) _Pragma("unroll") for (int k = 0; k < 2; ++k) dst[m][k] = *(const PG8_LAS bf16x8*)(lds + PG8_SA(b, h) + aoff + m * 2048 + k * 1024); } } while (0)
#define PG8_LDB(dst, b, h) do { if constexpr (FP8) { _Pragma("unroll") for (int n = 0; n < 2; ++n) dst##8[n] = __builtin_shufflevector(*(const PG8_LAS i32x4*)(lds + PG8_SB(b, h) + boff + n * 2048), *(const PG8_LAS i32x4*)(lds + PG8_SB(b, h) + boff + n * 2048 + 1024), 0, 1, 2, 3, 4, 5, 6, 7); } \
        else { _Pragma("unroll") for (int n = 0; n < 2; ++n) _Pragma("unroll") for (int k = 0; k < 2; ++k) dst[n][k] = *(const PG8_LAS bf16x8*)(lds + PG8_SB(b, h) + boff + n * 2048 + k * 1024); } } while (0)
#define PG8_MMA(ai, bj, At, Bt) do { __builtin_amdgcn_s_setprio(1); if constexpr (FP8) { _Pragma("unroll") for (int m = 0; m < 4; ++m) _Pragma("unroll") for (int n = 0; n < 2; ++n) \
        asm volatile("v_mfma_scale_f32_16x16x128_f8f6f4 %0, %1, %2, %0, %3, %4 op_sel_hi:[0,0,0]" : "+v"(acc[ai][bj][m][n]) : "v"(Bt##8[n]), "v"(At##8[m]), "v"(sc8w), "v"(sc8a)); } \
        else { _Pragma("unroll") for (int m = 0; m < 4; ++m) _Pragma("unroll") for (int n = 0; n < 2; ++n) _Pragma("unroll") for (int k = 0; k < 2; ++k) \
        acc[ai][bj][m][n] = __builtin_amdgcn_mfma_f32_16x16x32_bf16(Bt[n][k], At[m][k], acc[ai][bj][m][n], 0, 0, 0); } __builtin_amdgcn_s_setprio(0); } while (0)
#define PG8_WAIT_V(n) asm volatile("s_waitcnt vmcnt(" #n ")" ::: "memory")
#define PG8_WAIT_L(n) asm volatile("s_waitcnt lgkmcnt(" #n ")" ::: "memory")
#define PG8_BAR __builtin_amdgcn_s_barrier()
#define PG8_SCHED __builtin_amdgcn_sched_barrier(0)
    Unit cur, nxt; int ui = 0;
    if (!S.next(0, cur)) return;
    f32x4 acc[2][2][4][2]; f32x4 ini[2][2];
    if constexpr (Epi::HAS_INIT) E.load_init(ini, cur, wc, fq);
#pragma unroll
    for (int a = 0; a < 2; ++a)
#pragma unroll
        for (int b = 0; b < 2; ++b)
#pragma unroll
            for (int m = 0; m < 4; ++m)
#pragma unroll
                for (int n = 0; n < 2; ++n) { if constexpr (Epi::HAS_INIT) acc[a][b][m][n] = ini[b][n]; else acc[a][b][m][n] = (f32x4){0.f, 0.f, 0.f, 0.f}; }
    bf16x8 At[4][2], B0[2][2], B1[2][2]; i32x8 At8[4], B08[2], B18[2];
    int sc8w = 122, sc8a = 127; if constexpr (FP8) { sc8w = Epi::SCW; asm volatile("" : "+v"(sc8w), "+v"(sc8a)); }
    const char* cA = (const char*)g.A + (size_t)cur.pm * tstep; const char* cB = (const char*)g.Bt + (size_t)cur.pb * tstep;
    S.a_ready(cur);
    if constexpr (SP2) {
        if constexpr (GATHER) { PG8_GLOAD(gA, 0); }
        PG8_STAGE(PG8_SB(0, 0), cB, voffB); PG8_STAGE(PG8_SB(0, 1), cB + hstep, voffB); PG8_STA(0, 0, cA, 0, false); PG8_STA(0, 1, cA + hstep, 0, false);
        if (wr == 1) PG8_BAR;
        PG8_WAIT_V(2); PG8_BAR;
        PG8_STAGE(PG8_SB(1, 0), cB + kstep, voffB); PG8_STA(1, 0, cA + kstep, kstep, false); PG8_STAGE(PG8_SB(1, 1), cB + hstep + kstep, voffB);
        PG8_WAIT_V(6); PG8_BAR;
    } else {
        PG8_STAGE(PG8_SB(0, 0), cB, voffB); PG8_STAGE(PG8_SA(0, 0), cA, voffA); PG8_STAGE(PG8_SB(0, 1), cB + hstep, voffB); PG8_STAGE(PG8_SA(0, 1), cA + hstep, voffA);
        if (wr == 1) PG8_BAR;
        PG8_WAIT_V(4); PG8_BAR;
        PG8_STAGE(PG8_SB(1, 0), cB + kstep, voffB); PG8_STAGE(PG8_SA(1, 0), cA + kstep, voffA); PG8_STAGE(PG8_SB(1, 1), cB + hstep + kstep, voffB);
        PG8_WAIT_V(6); PG8_BAR;
    }
    for (;;) {
        const bool has_next = S.next(ui + 1, nxt);
        if constexpr (GATHER) { if (has_next) { PG8_GLOAD(gN, ui + 1); } else { _Pragma("unroll") for (int h_ = 0; h_ < 2; ++h_) _Pragma("unroll") for (int i_ = 0; i_ < 2; ++i_) gN[h_][i_] = gA[h_][i_]; } }
        const char* nA = has_next ? (const char*)g.A + (size_t)nxt.pm * tstep : cA; const char* nB = has_next ? (const char*)g.Bt + (size_t)nxt.pb * tstep : cB;
#pragma nounroll
        for (int t = 0; t < nt; t += 2) {
            const bool last = (t == nt - 2);
            const char* a1 = cA + (size_t)(t + 1) * kstep;
            const char* a2 = last ? nA : cA + (size_t)(t + 2) * kstep; const char* b2 = last ? nB : cB + (size_t)(t + 2) * kstep;
            const char* a3 = a2 + kstep; const char* b3 = b2 + kstep;
            const size_t ka2 = last ? 0 : (size_t)(t + 2) * kstep;
            if (last && has_next) S.a_ready(nxt);
            if constexpr (SP2) {
            PG8_LDB(B0, 0, 0); PG8_LDB(B1, 0, 1); PG8_SCHED; PG8_LDA(At, 0, 0); PG8_STA(1, 1, a1 + hstep, (size_t)(t + 1) * kstep, false);
            PG8_WAIT_V(8); PG8_WAIT_L(0); PG8_BAR; PG8_MMA(0, 0, At, B0); PG8_MMA(0, 1, At, B1); PG8_BAR; PG8_SCHED;
            PG8_LDA(At, 0, 1); PG8_STAGE(PG8_SB(0, 0), b2, voffB); PG8_STAGE(PG8_SB(0, 1), b2 + hstep, voffB); PG8_STA(0, 0, a2, ka2, last);
            PG8_WAIT_V(8); PG8_WAIT_L(0); PG8_BAR; PG8_MMA(1, 0, At, B0); PG8_MMA(1, 1, At, B1); PG8_BAR; PG8_SCHED;
            PG8_LDB(B0, 1, 0); PG8_LDB(B1, 1, 1); PG8_SCHED; PG8_LDA(At, 1, 0); PG8_STA(0, 1, a2 + hstep, ka2, last);
            PG8_WAIT_V(8); PG8_WAIT_L(0); PG8_BAR; PG8_MMA(0, 0, At, B0); PG8_MMA(0, 1, At, B1); PG8_BAR; PG8_SCHED;
            PG8_LDA(At, 1, 1); PG8_STAGE(PG8_SB(1, 0), b3, voffB); PG8_STAGE(PG8_SB(1, 1), b3 + hstep, voffB); PG8_STA(1, 0, a3, ka2 + kstep, last);
            PG8_WAIT_V(8); PG8_WAIT_L(0); PG8_BAR; PG8_MMA(1, 0, At, B0); PG8_MMA(1, 1, At, B1); PG8_BAR; PG8_SCHED;
            } else {
            PG8_LDB(B0, 0, 0); PG8_SCHED; PG8_LDA(At, 0, 0); PG8_STAGE(PG8_SA(1, 1), a1 + hstep, voffA);
            PG8_WAIT_L(8); PG8_BAR; PG8_WAIT_L(0); PG8_MMA(0, 0, At, B0); PG8_BAR; PG8_SCHED;
            PG8_LDB(B1, 0, 1); PG8_STAGE(PG8_SB(0, 0), b2, voffB);
            PG8_BAR; PG8_WAIT_L(0); PG8_MMA(0, 1, At, B1); PG8_BAR;
            PG8_LDA(At, 0, 1); PG8_STAGE(PG8_SA(0, 0), a2, voffA);
            PG8_BAR; PG8_WAIT_L(0); PG8_MMA(1, 0, At, B0); PG8_BAR; PG8_SCHED;
            PG8_STAGE(PG8_SB(0, 1), b2 + hstep, voffB);
            PG8_WAIT_V(6); PG8_BAR; PG8_MMA(1, 1, At, B1); PG8_BAR;
            PG8_LDB(B0, 1, 0); PG8_SCHED; PG8_LDA(At, 1, 0); PG8_STAGE(PG8_SA(0, 1), a2 + hstep, voffA);
            PG8_WAIT_L(8); PG8_BAR; PG8_WAIT_L(0); PG8_MMA(0, 0, At, B0); PG8_BAR; PG8_SCHED;
            PG8_LDB(B1, 1, 1); PG8_STAGE(PG8_SB(1, 0), b3, voffB);
            PG8_BAR; PG8_WAIT_L(0); PG8_MMA(0, 1, At, B1); PG8_BAR;
            PG8_LDA(At, 1, 1); PG8_STAGE(PG8_SA(1, 0), a3, voffA);
            PG8_BAR; PG8_WAIT_L(0); PG8_MMA(1, 0, At, B0); PG8_BAR; PG8_SCHED;
            PG8_STAGE(PG8_SB(1, 1), b3 + hstep, voffB);
            PG8_WAIT_V(6); PG8_BAR; PG8_MMA(1, 1, At, B1); PG8_BAR;
            }
        }
        if constexpr (ALIGN_EPI) { if (wr == 0) PG8_BAR; }
        if constexpr (FP8) asm volatile("s_nop 15\n\ts_nop 15" ::: "memory");
        if constexpr (Epi::HAS_INIT) { if (has_next) E.load_init(ini, nxt, wc, fq); }
        if constexpr (!Epi::AFTER_DRAIN) { E(acc, cur, wr, wc, fr, fq); S.done(cur); }
        if (!has_next) break;
#pragma unroll
        for (int a = 0; a < 2; ++a)
#pragma unroll
            for (int b = 0; b < 2; ++b)
#pragma unroll
                for (int m = 0; m < 4; ++m)
#pragma unroll
                    for (int n = 0; n < 2; ++n) { if constexpr (Epi::HAS_INIT) acc[a][b][m][n] = ini[b][n]; else acc[a][b][m][n] = (f32x4){0.f, 0.f, 0.f, 0.f}; }
        cur = nxt; cA = nA; cB = nB; ++ui;
        if constexpr (GATHER) { _Pragma("unroll") for (int h_ = 0; h_ < 2; ++h_) _Pragma("unroll") for (int i_ = 0; i_ < 2; ++i_) gA[h_][i_] = gN[h_][i_]; }
        if constexpr (ALIGN_EPI) { if (wr == 1) PG8_BAR; }
    }
    PG8_WAIT_V(0);
    if constexpr (!ALIGN_EPI) { if (wr == 0) PG8_BAR; }
    PG8_BAR;
    if constexpr (Epi::AFTER_DRAIN) { E.fused(acc, cur, wr, wc, fr, fq, lds, wid, lane); S.done(cur); }
#undef PG8_GLOAD
#undef PG8_STA
#undef PG8_SA
#undef PG8_SB
#undef PG8_STAGE
#undef PG8_LDA
#undef PG8_LDB
#undef PG8_MMA
#undef PG8_WAIT_V
#undef PG8_WAIT_L
#undef PG8_BAR
#undef PG8_SCHED
}
}

namespace att {
typedef short s16x4 __attribute__((ext_vector_type(4)));
typedef float f32x16 __attribute__((ext_vector_type(16)));
using pg8::bf16x8; using pg8::f32x4; using pg8::u32x4; using pg8::bf16_t;
constexpr int NW = 8, QBLK = 32, KVBLK = 64, QB = 256;
constexpr int SHM_V = 16384, SHM_KN = 16384, SHM_KR = 8192;
constexpr int OFF_V = 0, OFF_KN = 2 * SHM_V, OFF_KR = OFF_KN + 2 * SHM_KN, OFF_WS = OFF_KR + 2 * SHM_KR, LDS_BYTES = OFF_WS + NW * 64 * 4;
constexpr float SCALE = 0.07216878364870322f;
constexpr float THR = 8.f;
#define ATT_SBAR() __builtin_amdgcn_sched_barrier(0)
#define KSWZ(row, colB) ((row) * 256 + ((colB) ^ (((row) & 15) << 4)))
__device__ __forceinline__ int v_st(int k, int c) { const int kk = (k & ~0xC) | ((k & 4) << 1) | ((k & 8) >> 1); return ((kk >> 3) * 4 + (c >> 5)) * 512 + ((kk & 7) * 32 + (c & 31)) * 2; }
__device__ __forceinline__ int v_rd_base(int lane) { return ((lane & 3) << 3) | (((lane >> 2) & 3) << 6) | (((lane >> 4) & 1) << 5) | (((lane >> 5) & 1) << 8); }
constexpr int v_rd_off(int d0, int ks, int half) { return d0 * 512 + ks * 4096 + half * 2048; }
__device__ __forceinline__ int crow(int r, int hi) { return (r & 3) + 8 * (r >> 2) + 4 * hi; }
__device__ __forceinline__ unsigned cvtpk(float lo, float hi) { return pg8::cvt_pk_bf16(lo, hi); }

__device__ __forceinline__ void mask_tile(f32x16& p0, f32x16& p1, int dq) {
    const float NEG = -__builtin_inff();
#pragma unroll
    for (int r = 0; r < 16; ++r) {
        const int c = (r & 3) + 8 * (r >> 2);
        if (dq - c < 0) p0[r] = NEG;
        if (dq - c - 32 < 0) p1[r] = NEG;
    }
}
template <bool NOEXP = false, bool NOSM = false>
__device__ __forceinline__ void partialSM(f32x16& p0, f32x16& p1, float& m_reg, float& alpha) {
    if constexpr (NOSM) { alpha = 1.f; return; }
    float pmax = p0[0];
#pragma unroll
    for (int r = 1; r < 16; ++r) pmax = fmaxf(pmax, p0[r]);
#pragma unroll
    for (int r = 0; r < 16; ++r) pmax = fmaxf(pmax, p1[r]);
    { auto rr = __builtin_amdgcn_permlane32_swap(__float_as_uint(pmax), __float_as_uint(pmax), false, false);
      pmax = fmaxf(__uint_as_float(rr[0]), __uint_as_float(rr[1])); }
    constexpr float C2 = 1.4426950408889634f * SCALE;
    float mn;
    if (__builtin_expect(__all((pmax - m_reg) * SCALE <= THR), 1)) { mn = m_reg; alpha = 1.f; }
    else { mn = fmaxf(m_reg, pmax); alpha = __builtin_amdgcn_exp2f((m_reg - mn) * C2); m_reg = mn; }
    const float mnL = -mn * C2;
#pragma unroll
    for (int r = 0; r < 16; ++r) p0[r] = NOEXP ? fmaf(p0[r], C2, mnL) : __builtin_amdgcn_exp2f(fmaf(p0[r], C2, mnL));
#pragma unroll
    for (int r = 0; r < 16; ++r) p1[r] = NOEXP ? fmaf(p1[r], C2, mnL) : __builtin_amdgcn_exp2f(fmaf(p1[r], C2, mnL));
}
template <bool NOSUM = false>
__device__ __forceinline__ void finishSM(const f32x16& p0, const f32x16& p1, float alpha, float& l_reg, bf16x8& pa0, bf16x8& pa1, bf16x8& pa2, bf16x8& pa3) {
    float ps = 0;
    if constexpr (!NOSUM) {
#pragma unroll
    for (int r = 0; r < 16; ++r) ps += p0[r];
#pragma unroll
    for (int r = 0; r < 16; ++r) ps += p1[r];
    { auto rr = __builtin_amdgcn_permlane32_swap(__float_as_uint(ps), __float_as_uint(ps), false, false);
      ps = __uint_as_float(rr[0]) + __uint_as_float(rr[1]); }
    l_reg = l_reg * alpha + ps; }
#define ATT_PK4(P, B_, OUT) do { unsigned a0 = cvtpk(P[B_+0], P[B_+1]), a1 = cvtpk(P[B_+2], P[B_+3]);                          \
        unsigned b0 = cvtpk(P[B_+4], P[B_+5]), b1 = cvtpk(P[B_+6], P[B_+7]);                                             \
        auto r0 = __builtin_amdgcn_permlane32_swap(a0, b0, false, false); auto r1 = __builtin_amdgcn_permlane32_swap(a1, b1, false, false); \
        u32x4 w = {r0[0], r1[0], r0[1], r1[1]}; OUT = __builtin_bit_cast(bf16x8, w); } while (0)
    ATT_PK4(p0, 0, pa0); ATT_PK4(p0, 8, pa1); ATT_PK4(p1, 0, pa2); ATT_PK4(p1, 8, pa3);
#undef ATT_PK4
}
__device__ __forceinline__ void qkt(f32x16& p0, f32x16& p1, const LAS char* kn, const LAS char* kr, int r32, int hi, const bf16x8* qr) {
    p0 = f32x16{}; p1 = f32x16{};
    const int sw = ((r32 >> 1) & 7) << 4;
    const LAS char* kr0 = kr + r32 * 128;
    bf16x8 fa[3], fb[3];
#define ATT_KLD(i, slot) do { if ((i) < 8) { const LAS char* a_ = kn + KSWZ(r32, ((i) * 16 + hi * 8) * 2); fa[slot] = *(const LAS bf16x8*)a_; fb[slot] = *(const LAS bf16x8*)(a_ + 32 * 256); } \
        else { const LAS char* a_ = kr0 + (((2 * ((i) - 8) + hi) * 16) ^ sw); fa[slot] = *(const LAS bf16x8*)a_; fb[slot] = *(const LAS bf16x8*)(a_ + 32 * 128); } } while (0)
    ATT_KLD(0, 0); ATT_KLD(1, 1);
#pragma unroll
    for (int d0 = 0; d0 < 12; ++d0) {
        if (d0 + 2 < 12) ATT_KLD(d0 + 2, (d0 + 2) % 3);
        __builtin_amdgcn_sched_barrier(0);
        __builtin_amdgcn_s_setprio(1);
        p0 = __builtin_amdgcn_mfma_f32_32x32x16_bf16(fa[d0 % 3], qr[d0], p0, 0, 0, 0);
        p1 = __builtin_amdgcn_mfma_f32_32x32x16_bf16(fb[d0 % 3], qr[d0], p1, 0, 0, 0);
        __builtin_amdgcn_s_setprio(0);
        __builtin_amdgcn_sched_barrier(0);
    }
#undef ATT_KLD
}
struct VFrag { s16x4 l0, l1, l2, l3, h0, h1, h2, h3; };
#define ATT_TRRD(dst, off) asm volatile("ds_read_b64_tr_b16 %0, %1 offset:%2" : "=&v"(dst) : "v"(vb0), "i"(off) : "memory")
#define ATT_VLD(F, d0) do { constexpr int b_ = v_rd_off(d0, 0, 0); \
        ATT_TRRD(F.l0, b_); ATT_TRRD(F.h0, b_ + 2048); ATT_TRRD(F.l1, b_ + 4096); ATT_TRRD(F.h1, b_ + 6144); ATT_TRRD(F.l2, b_ + 8192); ATT_TRRD(F.h2, b_ + 10240); ATT_TRRD(F.l3, b_ + 12288); ATT_TRRD(F.h3, b_ + 14336); } while (0)
#define ATT_VMM(F, d0) do { __builtin_amdgcn_s_setprio(1); \
        o[d0] = __builtin_amdgcn_mfma_f32_32x32x16_bf16(pa0, (bf16x8){F.l0[0], F.l0[1], F.l0[2], F.l0[3], F.h0[0], F.h0[1], F.h0[2], F.h0[3]}, o[d0], 0, 0, 0);   \
        o[d0] = __builtin_amdgcn_mfma_f32_32x32x16_bf16(pa1, (bf16x8){F.l1[0], F.l1[1], F.l1[2], F.l1[3], F.h1[0], F.h1[1], F.h1[2], F.h1[3]}, o[d0], 0, 0, 0);   \
        o[d0] = __builtin_amdgcn_mfma_f32_32x32x16_bf16(pa2, (bf16x8){F.l2[0], F.l2[1], F.l2[2], F.l2[3], F.h2[0], F.h2[1], F.h2[2], F.h2[3]}, o[d0], 0, 0, 0);   \
        o[d0] = __builtin_amdgcn_mfma_f32_32x32x16_bf16(pa3, (bf16x8){F.l3[0], F.l3[1], F.l3[2], F.l3[3], F.h3[0], F.h3[1], F.h3[2], F.h3[3]}, o[d0], 0, 0, 0); __builtin_amdgcn_s_setprio(0); } while (0)
__device__ __forceinline__ void pv_pre(VFrag& fa, int vb0) { ATT_VLD(fa, 0); }
__device__ __forceinline__ void pv_tile(f32x16* o, int vb0, VFrag& fa, bf16x8 pa0, bf16x8 pa1, bf16x8 pa2, bf16x8 pa3) {
    VFrag fb;
    ATT_VLD(fb, 1); asm volatile("s_waitcnt lgkmcnt(8)" ::: "memory"); ATT_SBAR(); ATT_VMM(fa, 0); ATT_SBAR();
    ATT_VLD(fa, 2); asm volatile("s_waitcnt lgkmcnt(8)" ::: "memory"); ATT_SBAR(); ATT_VMM(fb, 1); ATT_SBAR();
    ATT_VLD(fb, 3); asm volatile("s_waitcnt lgkmcnt(8)" ::: "memory"); ATT_SBAR(); ATT_VMM(fa, 2); ATT_SBAR();
    asm volatile("s_waitcnt lgkmcnt(0)" ::: "memory"); ATT_SBAR(); ATT_VMM(fb, 3);
}
#undef ATT_VMM
#undef ATT_VLD
#undef ATT_TRRD

struct Tensors { const bf16_t* Q; const bf16_t* KN; const bf16_t* KR; const bf16_t* V; const bf16_t* GM; bf16_t* MIX; };

template <int VAR = 0>
__device__ __forceinline__ void attn_unit(const Tensors& X, int b, int h, int qb, LAS char* lds) {
    int tid_ = threadIdx.x; asm volatile("" : "+v"(tid_));
    const int tid = tid_, wid = __builtin_amdgcn_readfirstlane(tid >> 6), lane = tid & 63, r32 = lane & 31, hi = lane >> 5;
    const size_t tok0 = (size_t)b * 4096;
    const int q0 = qb * QB, qlo = q0 + wid * QBLK;
    const int NT = (q0 + QB) / KVBLK;
    bf16x8 qr[12];
    { const bf16_t* qp = X.Q + (tok0 + qlo + r32) * 1536 + h * 192 + hi * 8;
#pragma unroll
      for (int d0 = 0; d0 < 12; ++d0) qr[d0] = *(const bf16x8*)(qp + d0 * 16); }
    const char* Vu = (const char*)(X.V + tok0 * 1024 + h * 128); const char* Ku = (const char*)(X.KN + tok0 * 1024 + h * 128); const char* Ru = (const char*)(X.KR + tok0 * 64);
    unsigned koff[2], voff[2], roff;
#pragma unroll
    for (int j = 0; j < 2; ++j) {
        { const int r = 4 * (2 * wid + j) + (lane >> 4), p = lane & 15; koff[j] = (unsigned)(r * 2048 + ((p ^ (r & 15)) << 4)); }
        { const int blk = 2 * (2 * wid + j) + (lane >> 5), q = lane & 31, kk = (blk >> 2) * 8 + (q >> 2), c = (blk & 3) * 32 + (q & 3) * 8;
          const int k = (kk & ~0xC) | ((kk & 4) << 1) | ((kk & 8) >> 1); voff[j] = (unsigned)(k * 2048 + c * 2); } }
    { const int rr = 8 * wid + (lane >> 3), p = lane & 7; roff = (unsigned)(rr * 128 + ((p ^ ((rr >> 1) & 7)) << 4)); }
    float* wsf = (float*)(lds + OFF_WS) + wid * 64;
    LAS float* wsl = (LAS float*)(lds + OFF_WS) + wid * 64; (void)wsf;
    const int vbase = (int)(unsigned)(uintptr_t)(lds + OFF_V) + v_rd_base(lane);
#define ATT_DMA(t, bf) do { const size_t k0_ = (size_t)(t) * KVBLK; _Pragma("unroll") for (int j_ = 0; j_ < 2; ++j_) { \
            __builtin_amdgcn_global_load_lds((const unsigned*)(Ku + k0_ * 2048 + koff[j_]), (LAS unsigned*)(lds + OFF_KN + (bf) * SHM_KN + (2 * wid + j_) * 1024), 16, 0, 0); \
            __builtin_amdgcn_global_load_lds((const unsigned*)(Vu + k0_ * 2048 + voff[j_]), (LAS unsigned*)(lds + OFF_V + (bf) * SHM_V + (2 * wid + j_) * 1024), 16, 0, 0); } \
        __builtin_amdgcn_global_load_lds((const unsigned*)(Ru + k0_ * 128 + roff), (LAS unsigned*)(lds + OFF_KR + (bf) * SHM_KR + wid * 1024), 16, 0, 0); } while (0)
    float m_reg = -1e30f, l_reg = 0.f; f32x16 o[4] = {};
    asm volatile("" : "+v"(qr[0]), "+v"(qr[1]), "+v"(qr[2]), "+v"(qr[3]), "+v"(qr[4]), "+v"(qr[5]), "+v"(qr[6]), "+v"(qr[7]), "+v"(qr[8]), "+v"(qr[9]), "+v"(qr[10]), "+v"(qr[11]));
    ATT_DMA(0, 0);
    asm volatile("s_waitcnt vmcnt(0)" ::: "memory");
    __syncthreads();
#define ATT_ITER(t) do { const int bf = (t) & 1; \
        if constexpr (!(VAR & 32)) ATT_DMA((t) + 1 < NT ? (t) + 1 : NT - 1, bf ^ 1);        \
        const int kb = (t) * KVBLK; \
        if (kb <= qlo + QBLK - 1) { \
            f32x16 p0, p1; float alpha; bf16x8 pa0, pa1, pa2, pa3; VFrag vf; \
            if constexpr (VAR & 4) { _Pragma("unroll") for (int r = 0; r < 16; ++r) { p0[r] = __uint_as_float(qr[r % 12][0] << 16); p1[r] = __uint_as_float(qr[r % 12][1] << 16); } } else \
            qkt(p0, p1, lds + OFF_KN + bf * SHM_KN, lds + OFF_KR + bf * SHM_KR, r32, hi, qr); \
            if (kb + KVBLK - 1 > qlo) mask_tile(p0, p1, qlo + r32 - kb - 4 * hi); \
            partialSM<(VAR & 1) != 0, (VAR & 16) != 0>(p0, p1, m_reg, alpha); \
            if (__any(alpha < 1.f)) { \
                if (hi == 0) wsl[r32] = alpha; \
                asm volatile("s_waitcnt lgkmcnt(0)" ::: "memory"); \
                _Pragma("unroll") for (int d_ = 0; d_ < 4; ++d_) _Pragma("unroll") for (int r = 0; r < 16; ++r) o[d_][r] *= wsl[crow(r, hi)]; \
            } \
            finishSM<(VAR & 16) != 0>(p0, p1, alpha, l_reg, pa0, pa1, pa2, pa3); \
            pv_pre(vf, vbase + bf * SHM_V); \
            ATT_SBAR(); \
            if constexpr (VAR & 8) { asm volatile("s_waitcnt lgkmcnt(0)" ::: "memory"); o[0][0] += __uint_as_float((unsigned)pa0[0] << 16) + __uint_as_float((unsigned)vf.l0[0] << 16); } else \
            pv_tile(o, vbase + bf * SHM_V, vf, pa0, pa1, pa2, pa3); \
        } \
        if constexpr (VAR & 2) asm volatile("s_waitcnt vmcnt(0) lgkmcnt(0)" ::: "memory"); else asm volatile("s_waitcnt vmcnt(0) lgkmcnt(0)\n\ts_barrier" ::: "memory"); } while (0)
#pragma unroll 1
    for (int t = 0; t < NT; t += 2) {
        ATT_ITER(t);
        ATT_ITER(t + 1);
    }
#undef ATT_ITER
    if (hi == 0) wsl[32 + r32] = l_reg;
    asm volatile("s_waitcnt lgkmcnt(0)" ::: "memory");
    float rli[16];
#pragma unroll
    for (int r = 0; r < 16; ++r) rli[r] = __builtin_amdgcn_rcpf(wsl[32 + crow(r, hi)]);
#pragma unroll
    for (int rh = 0; rh < 16; rh += 8) {
        unsigned short gmv[8][4];
#pragma unroll
        for (int r = 0; r < 8; ++r) { const size_t trow = tok0 + qlo + crow(rh + r, hi);
#pragma unroll
            for (int d0 = 0; d0 < 4; ++d0) gmv[r][d0] = X.GM[trow * 1024 + h * 128 + d0 * 32 + r32]; }
#pragma unroll
        for (int r = 0; r < 8; ++r) { const size_t trow = tok0 + qlo + crow(rh + r, hi);
#pragma unroll
            for (int d0 = 0; d0 < 4; ++d0) { const size_t off = trow * 1024 + h * 128 + d0 * 32 + r32;
                const float g = __uint_as_float((unsigned)gmv[r][d0] << 16);
                const float v = o[d0][rh + r] * rli[rh + r] * g;
                const float vn = __shfl_xor(v, 1);
                if ((r32 & 1) == 0) *(unsigned*)(X.MIX + off) = cvtpk(v, vn); } }
    }
    __syncthreads();
#undef ATT_DMA
}
template <int VAR = 0>
__device__ __forceinline__ void attn_phase(const Tensors& X, LAS char* lds, int vcu, int G) {
    for (int it = vcu; it < 256; it += G) {
        const int bh = it >> 3, x = it & 7;
        attn_unit<VAR>(X, bh >> 3, bh & 7, 15 - x, lds);
        attn_unit<VAR>(X, bh >> 3, bh & 7, x, lds);
    }
}
#undef KSWZ
#undef ATT_SBAR
}

#ifndef RET_PIPE
#define RET_PIPE 1
#endif
#ifndef RET_WIDE
#define RET_WIDE 1
#endif
#ifndef RET_REP
#define RET_REP 1
#endif
namespace ret {
using pg8::bf16x8; using pg8::f32x4; using pg8::u32x4; using pg8::bf16_t; using pg8::u32x2;
typedef short v4i16 __attribute__((ext_vector_type(4)));
constexpr int RS = 288;
constexpr int TILE = 128 * RS;
__device__ __forceinline__ float bf2f(short s) { return __uint_as_float(((unsigned)(unsigned short)s) << 16); }
__device__ __forceinline__ float lg2_gamma(int h) { const float x = exp2f(-5.0f - (float)h);
    return -x * (1.0f + x * (0.5f + x * (0.33333334f + x * (0.25f + x * (0.2f + x * 0.16666667f))))) * 1.4426950408889634f; }
struct Tile { bf16x8 v[4]; };
template <bool NT = false> __device__ __forceinline__ void tile_load(Tile& t, const bf16_t* src, size_t pitch, int tid) {
#pragma unroll
    for (int c = 0; c < 4; ++c) { const int idx = tid + 512 * c; const bf16x8* p = (const bf16x8*)(src + (size_t)(idx >> 4) * pitch + (idx & 15) * 8); t.v[c] = NT ? __builtin_nontemporal_load(p) : *p; }
}
template <bool SCALE> __device__ __forceinline__ void tile_store(const Tile& t, LAS char* slot, float lg2, int tid) {
#pragma unroll
    for (int c = 0; c < 4; ++c) { const int idx = tid + 512 * c, row = idx >> 4; bf16x8 v = t.v[c];
        if (SCALE) { const float w = exp2f((float)(127 - row) * lg2); u32x4 o;
            o.x = pg8::cvt_pk_bf16(bf2f(v[0]) * w, bf2f(v[1]) * w); o.y = pg8::cvt_pk_bf16(bf2f(v[2]) * w, bf2f(v[3]) * w); o.z = pg8::cvt_pk_bf16(bf2f(v[4]) * w, bf2f(v[5]) * w); o.w = pg8::cvt_pk_bf16(bf2f(v[6]) * w, bf2f(v[7]) * w);
            v = __builtin_bit_cast(bf16x8, o); }
        *(LAS bf16x8*)(slot + row * RS + (idx & 15) * 16) = v; }
}
__device__ __forceinline__ bf16x8 tr_frag(const LAS char* tile, int trb, int j0, int c0) {
    const LAS char* p = tile + trb + j0 * RS + c0 * 2;
    const v4i16 lo = __builtin_amdgcn_ds_read_tr16_b64_v4i16((LAS v4i16*)p), hi = __builtin_amdgcn_ds_read_tr16_b64_v4i16((LAS v4i16*)(p + 16 * RS));
    return (bf16x8){lo[0], lo[1], lo[2], lo[3], hi[0], hi[1], hi[2], hi[3]};
}
__device__ __forceinline__ void u_phase(const bf16_t* RK, const bf16_t* RV, bf16_t* UT, int vcu, int G, LAS char* lds) {
    int tid_ = threadIdx.x; asm volatile("" : "+v"(tid_));
    const int tid = tid_, wid = __builtin_amdgcn_readfirstlane(tid >> 6), lane = tid & 63, fr = lane & 15, fq = lane >> 4;
    const int trb = (((lane & 15) >> 2) + 4 * fq) * RS + (lane & 3) * 8;
    LAS char* Ks = lds; LAS char* Vs = lds + TILE;
    Tile tk, tv; int u = vcu;
    if (u < 1024) { const int bh = u >> 5, n = u & 31; const size_t off = ((size_t)(bh >> 3) * 4096 + (size_t)n * 128) * 1024 + (bh & 7) * 128; tile_load(tk, RK + off, 1024, tid); tile_load(tv, RV + off, 1024, tid); }
    for (; u < 1024; u += G) {
        const int bh = u >> 5, n = u & 31, h = bh & 7;
        tile_store<true>(tk, Ks, lg2_gamma(h), tid); tile_store<false>(tv, Vs, 0.f, tid);
        __syncthreads();
        if (u + G < 1024) { const int u2 = u + G, bh2 = u2 >> 5, n2 = u2 & 31; const size_t off = ((size_t)(bh2 >> 3) * 4096 + (size_t)n2 * 128) * 1024 + (bh2 & 7) * 128; tile_load(tk, RK + off, 1024, tid); tile_load(tv, RV + off, 1024, tid); }
        bf16x8 yf[4];
#pragma unroll
        for (int ks = 0; ks < 4; ++ks) yf[ks] = tr_frag(Vs, trb, 32 * ks, 16 * wid);
        LAS float* stg = (LAS float*)(lds + 2 * TILE) + wid * (16 * 132);
#pragma unroll
        for (int db = 0; db < 8; ++db) { f32x4 acc = {0.f, 0.f, 0.f, 0.f};
#pragma unroll
            for (int ks = 0; ks < 4; ++ks) acc = __builtin_amdgcn_mfma_f32_16x16x32_bf16(tr_frag(Ks, trb, 32 * ks, 16 * db), yf[ks], acc, 0, 0, 0);
            *(LAS f32x4*)(stg + fr * 132 + 16 * db + 4 * fq) = acc; }
        asm volatile("s_waitcnt lgkmcnt(0)" ::: "memory");
        { bf16_t* out = UT + ((size_t)(bh * 32 + n) * 128 + 16 * wid) * 128;
#pragma unroll
          for (int i = 0; i < 4; ++i) { const int row = 4 * i + (lane >> 4), c8 = (lane & 15) * 8; const f32x4 a = *(const LAS f32x4*)(stg + row * 132 + c8), b = *(const LAS f32x4*)(stg + row * 132 + c8 + 4);
              *(u32x4*)(out + (size_t)row * 128 + c8) = pg8::pack8(a, b); } }
        __syncthreads();
    }
}
__device__ __forceinline__ void scan_all(const bf16_t* UT, bf16_t* RT, int gtid, int gthreads) {
    for (int g = gtid; g < 32 * 4096; g += gthreads) { const int bh = g >> 12, q4 = g & 4095, h = bh & 7;
        const float cd = exp2f(128.0f * lg2_gamma(h));
        const bf16_t* up = UT + (size_t)bh * 32 * 16384 + (size_t)q4 * 4; bf16_t* rp = RT + (size_t)bh * 32 * 16384 + (size_t)q4 * 4;
        u32x2 uw[32];
#pragma unroll
        for (int n = 0; n < 32; ++n) uw[n] = __builtin_nontemporal_load((const u32x2*)(up + (size_t)n * 16384));
        f32x4 R = {0.f, 0.f, 0.f, 0.f};
#pragma unroll
        for (int n = 0; n < 32; ++n) { const f32x4 u = {__uint_as_float(uw[n].x << 16), __uint_as_float(uw[n].x & 0xffff0000u), __uint_as_float(uw[n].y << 16), __uint_as_float(uw[n].y & 0xffff0000u)};
            u32x2 w; w.x = pg8::cvt_pk_bf16(R[0], R[1]); w.y = pg8::cvt_pk_bf16(R[2], R[3]);
            *(u32x2*)(rp + (size_t)n * 16384) = w;
            R = R * cd + u; } }
}
__device__ __forceinline__ void out_phase(const bf16_t* RQ, const bf16_t* RK, const bf16_t* RV, const bf16_t* RT, const bf16_t* GR, const bf16_t* MIX, bf16_t* MIXO, int vcu, int G, LAS char* lds) {
    int tid_ = threadIdx.x; asm volatile("" : "+v"(tid_));
    const int tid = tid_, wid = __builtin_amdgcn_readfirstlane(tid >> 6), lane = tid & 63, fr = lane & 15, fq = lane >> 4;
    const int trb = (((lane & 15) >> 2) + 4 * fq) * RS + (lane & 3) * 8;
    const int il0 = 16 * wid + fr;
    LAS char* Rs = lds; LAS char* Ks = lds + TILE; LAS char* Vs = lds + 2 * TILE;
    Tile tr, tk, tv; bf16x8 qn[4]; int u = vcu;
#define RET_LOAD(uu) do { const int bh_ = (uu) >> 5, n_ = (uu) & 31; const size_t off_ = ((size_t)(bh_ >> 3) * 4096 + (size_t)n_ * 128) * 1024 + (bh_ & 7) * 128; \
        tile_load<true>(tr, RT + (size_t)(bh_ * 32 + n_) * 16384, 128, tid); tile_load<true>(tk, RK + off_, 1024, tid); tile_load<true>(tv, RV + off_, 1024, tid); \
        _Pragma("unroll") for (int ks = 0; ks < 4; ++ks) qn[ks] = __builtin_nontemporal_load((const bf16x8*)(RQ + off_ + (size_t)il0 * 1024 + 32 * ks + 8 * fq)); } while (0)
    if (u < 1024) RET_LOAD(u);
    for (; u < 1024; u += G) {
        const int bh = u >> 5, n = u & 31, h = bh & 7; const float lg2 = lg2_gamma(h);
        int il = il0; asm volatile("" : "+v"(il));
        const size_t trow = (size_t)(bh >> 3) * 4096 + (size_t)n * 128 + il;
        tile_store<false>(tr, Rs, 0.f, tid); tile_store<false>(tk, Ks, 0.f, tid); tile_store<false>(tv, Vs, 0.f, tid);
        bf16x8 yq[4];
#pragma unroll
        for (int ks = 0; ks < 4; ++ks) yq[ks] = qn[ks];
        __syncthreads();
#if RET_WIDE
        u32x4 gv[4], mv[4];
        const int sw = fq & 1, pw = fq >> 1;
#pragma unroll
        for (int k = 0; k < 4; ++k) { const size_t off = trow * 1024 + h * 128 + 16 * (2 * k + sw) + 8 * pw; gv[k] = __builtin_nontemporal_load((const u32x4*)(GR + off)); mv[k] = __builtin_nontemporal_load((const u32x4*)(MIX + off)); }
#else
        u32x2 gv[8], mv[8];
#pragma unroll
        for (int eb = 0; eb < 8; ++eb) { const size_t off = trow * 1024 + h * 128 + 16 * eb + 4 * fq; gv[eb] = __builtin_nontemporal_load((const u32x2*)(GR + off)); mv[eb] = __builtin_nontemporal_load((const u32x2*)(MIX + off)); }
#endif
        { const int un = u + G < 1024 ? u + G : u; RET_LOAD(un); }
        f32x4 acc[8];
        u32x2 sb[8];
#if RET_REP > 1
#pragma nounroll
        for (int rep_ = 0; rep_ < RET_REP; ++rep_) { asm volatile("" ::: "memory");
#endif
#if RET_PIPE
        bf16x8 fA[4], fB[4];
#define RD_ROW(F, base, blk) _Pragma("unroll") for (int ks = 0; ks < 4; ++ks) F[ks] = *(const LAS bf16x8*)((base) + (16 * (blk) + fr) * RS + (32 * ks + 8 * fq) * 2)
#define RD_TR(F, st, hf) _Pragma("unroll") for (int e = 0; e < 4; ++e) F[e] = tr_frag(Vs, trb, 32 * (st), 16 * (4 * (hf) + e))
#define MM4(F, a) _Pragma("unroll") for (int ks = 0; ks < 4; ++ks) a = __builtin_amdgcn_mfma_f32_16x16x32_bf16(F[ks], yq[ks], a, 0, 0, 0)
#define SBAR() __builtin_amdgcn_sched_barrier(0)
        RD_ROW(fA, Rs, 0);
#pragma unroll
        for (int e2 = 0; e2 < 4; ++e2) {
            RD_ROW(fB, Rs, 2 * e2 + 1); SBAR();
            acc[2 * e2] = (f32x4){0.f, 0.f, 0.f, 0.f}; MM4(fA, acc[2 * e2]); SBAR();
            if (e2 < 3) { RD_ROW(fA, Rs, 2 * e2 + 2); } else { RD_ROW(fA, Ks, 0); }
            SBAR();
            acc[2 * e2 + 1] = (f32x4){0.f, 0.f, 0.f, 0.f}; MM4(fB, acc[2 * e2 + 1]); SBAR();
        }
        { const float qw = exp2f((float)(il + 1) * lg2);
#pragma unroll
          for (int eb = 0; eb < 8; ++eb) acc[eb] = acc[eb] * qw; }
#define SC_FIN(jb, s) do { _Pragma("unroll") for (int r = 0; r < 4; ++r) { const int dl = il - (16 * (jb) + 4 * fq + r); s[r] = dl >= 0 ? s[r] * exp2f((float)dl * lg2) : 0.f; } \
            sb[jb].x = pg8::cvt_pk_bf16(s[0], s[1]); sb[jb].y = pg8::cvt_pk_bf16(s[2], s[3]); } while (0)
#pragma unroll
        for (int j2 = 0; j2 < 4; ++j2) { sb[2 * j2] = (u32x2){0u, 0u}; sb[2 * j2 + 1] = (u32x2){0u, 0u};
            if (2 * j2 <= wid) {
                if (2 * j2 + 1 <= wid) { RD_ROW(fB, Ks, 2 * j2 + 1); }
                SBAR();
                f32x4 s = {0.f, 0.f, 0.f, 0.f}; MM4(fA, s); SC_FIN(2 * j2, s); SBAR();
                if (2 * j2 + 1 <= wid) {
                    if (j2 < 3 && 2 * j2 + 2 <= wid) { RD_ROW(fA, Ks, 2 * j2 + 2); }
                    SBAR();
                    f32x4 s1 = {0.f, 0.f, 0.f, 0.f}; MM4(fB, s1); SC_FIN(2 * j2 + 1, s1); SBAR();
                } } }
        RD_TR(fA, 0, 0);
#pragma unroll
        for (int st = 0; st < 4; ++st) {
            if (2 * st <= wid) { const u32x4 yw = {sb[2 * st].x, sb[2 * st].y, sb[2 * st + 1].x, sb[2 * st + 1].y}; const bf16x8 ys = __builtin_bit_cast(bf16x8, yw);
                RD_TR(fB, st, 1); SBAR();
#pragma unroll
                for (int e = 0; e < 4; ++e) acc[e] = __builtin_amdgcn_mfma_f32_16x16x32_bf16(fA[e], ys, acc[e], 0, 0, 0);
                SBAR();
                if (st < 3 && 2 * st + 2 <= wid) { RD_TR(fA, st + 1, 0); }
                SBAR();
#pragma unroll
                for (int e = 0; e < 4; ++e) acc[4 + e] = __builtin_amdgcn_mfma_f32_16x16x32_bf16(fB[e], ys, acc[4 + e], 0, 0, 0);
                SBAR(); } }
#undef RD_ROW
#undef RD_TR
#undef MM4
#undef SBAR
#undef SC_FIN
#else
#pragma unroll
        for (int eb = 0; eb < 8; ++eb) { acc[eb] = (f32x4){0.f, 0.f, 0.f, 0.f};
#pragma unroll
            for (int ks = 0; ks < 4; ++ks) acc[eb] = __builtin_amdgcn_mfma_f32_16x16x32_bf16(*(const LAS bf16x8*)(Rs + (16 * eb + fr) * RS + (32 * ks + 8 * fq) * 2), yq[ks], acc[eb], 0, 0, 0); }
        { const float qw = exp2f((float)(il + 1) * lg2);
#pragma unroll
          for (int eb = 0; eb < 8; ++eb) acc[eb] = acc[eb] * qw; }
#pragma unroll
        for (int jb = 0; jb < 8; ++jb) { sb[jb] = (u32x2){0u, 0u};
            if (jb <= wid) { f32x4 s = {0.f, 0.f, 0.f, 0.f};
#pragma unroll
                for (int ks = 0; ks < 4; ++ks) s = __builtin_amdgcn_mfma_f32_16x16x32_bf16(*(const LAS bf16x8*)(Ks + (16 * jb + fr) * RS + (32 * ks + 8 * fq) * 2), yq[ks], s, 0, 0, 0);
#pragma unroll
                for (int r = 0; r < 4; ++r) { const int dl = il - (16 * jb + 4 * fq + r); s[r] = dl >= 0 ? s[r] * exp2f((float)dl * lg2) : 0.f; }
                sb[jb].x = pg8::cvt_pk_bf16(s[0], s[1]); sb[jb].y = pg8::cvt_pk_bf16(s[2], s[3]); } }
#pragma unroll
        for (int st = 0; st < 4; ++st) {
            if (2 * st <= wid) { const u32x4 yw = {sb[2 * st].x, sb[2 * st].y, sb[2 * st + 1].x, sb[2 * st + 1].y}; const bf16x8 ys = __builtin_bit_cast(bf16x8, yw);
#pragma unroll
                for (int eb = 0; eb < 8; ++eb) acc[eb] = __builtin_amdgcn_mfma_f32_16x16x32_bf16(tr_frag(Vs, trb, 32 * st, 16 * eb), ys, acc[eb], 0, 0, 0); } }
#endif
#if RET_REP > 1
        }
#endif
        float s1 = 0.f;
#pragma unroll
        for (int eb = 0; eb < 8; ++eb) s1 += (acc[eb][0] + acc[eb][1]) + (acc[eb][2] + acc[eb][3]);
        s1 += __shfl_xor(s1, 16); s1 += __shfl_xor(s1, 32);
        const float mu = s1 * (1.0f / 128.0f); float s2 = 0.f;
#pragma unroll
        for (int eb = 0; eb < 8; ++eb) { const f32x4 d = acc[eb] - mu; s2 += (d[0] * d[0] + d[1] * d[1]) + (d[2] * d[2] + d[3] * d[3]); }
        s2 += __shfl_xor(s2, 16); s2 += __shfl_xor(s2, 32);
        const float rstd = __builtin_amdgcn_rsqf(s2 * (1.0f / 128.0f) + 1e-6f);
#if RET_WIDE
#pragma unroll
        for (int k = 0; k < 4; ++k) { const size_t off = trow * 1024 + h * 128 + 16 * (2 * k + sw) + 8 * pw;
            const f32x4 a0 = (acc[2 * k] - mu) * rstd, a1 = (acc[2 * k + 1] - mu) * rstd;
            const unsigned ax = pg8::cvt_pk_bf16(a0[0], a0[1]), ay = pg8::cvt_pk_bf16(a0[2], a0[3]), bx = pg8::cvt_pk_bf16(a1[0], a1[1]), by = pg8::cvt_pk_bf16(a1[2], a1[3]);
            const auto sx = __builtin_amdgcn_permlane16_swap(ax, bx, false, false); const auto sy = __builtin_amdgcn_permlane16_swap(ay, by, false, false);
            const unsigned o[4] = {sx[0], sy[0], sx[1], sy[1]};
            const u32x4 g = gv[k], mx = mv[k]; u32x4 w;
#pragma unroll
            for (int q = 0; q < 4; ++q) { const float r0 = __uint_as_float(mx[q] << 16) + __uint_as_float(g[q] << 16) * __uint_as_float(o[q] << 16), r1 = __uint_as_float(mx[q] & 0xffff0000u) + __uint_as_float(g[q] & 0xffff0000u) * __uint_as_float(o[q] & 0xffff0000u);
                w[q] = pg8::cvt_pk_bf16(r0, r1); }
            *(u32x4*)(MIXO + off) = w; }
#else
#pragma unroll
        for (int eb = 0; eb < 8; ++eb) { const size_t off = trow * 1024 + h * 128 + 16 * eb + 4 * fq;
            const u32x2 g = gv[eb], mx = mv[eb];
            const float o0 = (acc[eb][0] - mu) * rstd, o1 = (acc[eb][1] - mu) * rstd, o2 = (acc[eb][2] - mu) * rstd, o3 = (acc[eb][3] - mu) * rstd;
            const float r0 = __uint_as_float(mx.x << 16) + __uint_as_float(g.x << 16) * o0, r1 = __uint_as_float(mx.x & 0xffff0000u) + __uint_as_float(g.x & 0xffff0000u) * o1;
            const float r2 = __uint_as_float(mx.y << 16) + __uint_as_float(g.y << 16) * o2, r3 = __uint_as_float(mx.y & 0xffff0000u) + __uint_as_float(g.y & 0xffff0000u) * o3;
            u32x2 w; w.x = pg8::cvt_pk_bf16(r0, r1); w.y = pg8::cvt_pk_bf16(r2, r3);
            *(u32x2*)(MIXO + off) = w; }
#endif
        __syncthreads();
    }
#undef RET_LOAD
}
}

constexpr int NWAVES = 8;
#ifndef MK_PER_PHASE
#define MK_PER_PHASE 0
#endif
constexpr int NPH = 11;
constexpr int NB = 4, SEQ = 4096, T = NB * SEQ, DM = 1024;
constexpr int NP1 = 6912;
constexpr int NE = 32, PMAX = T * 4 + NE * 256, MT_MAX = PMAX / 256;
constexpr float LN_EPS = 1e-5f, DN_ALPHA = 1.189207115002721f;

constexpr size_t MiB = 1u << 20;
constexpr size_t WS_CTL = 0, CTL_ZERO_BYTES = 1 * MiB;
constexpr size_t WS_WIN = 1 * MiB, WS_WUQ = 15 * MiB, WS_WUKV = 17 * MiB, WS_WO = 18 * MiB, WS_WUP = 20 * MiB, WS_WDN = 148 * MiB;
constexpr size_t WS_XB = 212 * MiB, WS_COSM = 244 * MiB, WS_SINM = 246 * MiB, WS_COSR = 248 * MiB, WS_SINR = 252 * MiB;
constexpr size_t WS_Y = 256 * MiB, WS_H1 = 320 * MiB, WS_H1B = 384 * MiB;
constexpr size_t WS_TOPI = 416 * MiB, WS_GATE = WS_TOPI + 512 * 1024, WS_RANK = WS_GATE + 512 * 1024, WS_SLOT = WS_RANK + 512 * 1024, WS_TILEE = WS_SLOT + 512 * 1024, WS_ROWTOK = WS_TILEE + 64 * 1024, WS_SSQQ = 419 * MiB, WS_SSQKV = WS_SSQQ + 512 * 1024;
constexpr size_t WS_OV = 420 * MiB;
constexpr size_t WS_CQ = WS_OV, WS_CKV = WS_OV + 12 * MiB, WS_KR = WS_OV + 20 * MiB, WS_RQ = WS_OV + 22 * MiB, WS_RK = WS_OV + 54 * MiB, WS_RV = WS_OV + 86 * MiB,
                 WS_GR = WS_OV + 118 * MiB, WS_GM = WS_OV + 150 * MiB, WS_QB = WS_OV + 182 * MiB, WS_KN = WS_OV + 230 * MiB, WS_VB = WS_OV + 262 * MiB,
                 WS_UT = WS_OV + 294 * MiB, WS_RT = WS_OV + 358 * MiB, WS_MIX = WS_OV + 390 * MiB;
constexpr size_t WS_H1Q = WS_OV  , WS_XS = WS_OV, WS_A2 = WS_OV + 144 * MiB, WS_YS = WS_OV + 288 * MiB, WS_END = WS_OV + 432 * MiB;
static_assert((size_t)PMAX * 1024 * 2 == 144 * MiB && WS_MIX + 32 * MiB <= WS_END && WS_END <= 1024 * MiB, "d_ws map");

constexpr int CW_TMO = 0, CW_CODE = 1, CW_BAR = 4096, CW_CNT = 8192, CW_NMT = 8256, CW_SSQQ = 16384, CW_SSQKV = 32768;

constexpr int RING_OFF = 0, RING_BYTES = 131072;
constexpr int RT_W_BYTES = 1024 * 36 * 4;
constexpr int RT_LIST_OFF = RT_W_BYTES;
constexpr int RT_SCR_OFF = RT_LIST_OFF + 1024;
constexpr int MISC_OFF = 151552, LDS_BYTES = 152576;
static_assert(RT_SCR_OFF + 8 * 384 <= MISC_OFF && MISC_OFF + 128 <= LDS_BYTES, "LDS map");

#define GAS __attribute__((address_space(1)))
typedef unsigned short bf16;
typedef unsigned v4u __attribute__((ext_vector_type(4)));
typedef unsigned v2u __attribute__((ext_vector_type(2)));
typedef int i32x4 __attribute__((ext_vector_type(4)));
typedef float f32x4 __attribute__((ext_vector_type(4)));
typedef GAS unsigned gu32;
#define RLX_AGENT __ATOMIC_RELAXED, __HIP_MEMORY_SCOPE_AGENT
#define LDS_WAIT() asm volatile("s_waitcnt lgkmcnt(0)" ::: "memory")
#define VM_WAIT() asm volatile("s_waitcnt vmcnt(0)" ::: "memory")
__device__ __forceinline__ unsigned f2bf(float f) { unsigned u = __builtin_bit_cast(unsigned, f); return (u + 0x7fffu + ((u >> 16) & 1u)) >> 16; }
__device__ __forceinline__ unsigned pk2(float lo, float hi) { return f2bf(lo) | (f2bf(hi) << 16); }

#define XB_TMO      128
#define XB_XCNT(j)  (256  + 64 * (j))
#define XB_XSUB(j)  (1280 + 64 * (j))
#define XB_XGEN(j)  (2304 + 64 * (j))
#define XB_TOP      3328
#define XB_TOPGEN   3392
#define XCD_BAR_WORDS 3456
#define XB_SPIN_CAP (1u << 18)

__device__ __forceinline__ unsigned xb_ld(unsigned* p)              { return __hip_atomic_load(p, __ATOMIC_RELAXED, __HIP_MEMORY_SCOPE_AGENT); }
__device__ __forceinline__ unsigned xb_add(unsigned* p, unsigned v) { return __hip_atomic_fetch_add(p, v, __ATOMIC_RELAXED, __HIP_MEMORY_SCOPE_AGENT); }
__device__ __forceinline__ unsigned xb_xcc_id() { return (unsigned)__builtin_amdgcn_s_getreg((3 << 11) | 20) & 0xFu; }
#define XB_SPIN(cond, bar) do { unsigned _sp = 0; while (cond) { __builtin_amdgcn_s_sleep(1); \
    if ((++_sp & 255u) == 0u) { if (xb_ld(&(bar)[XB_TMO])) break; if (_sp > XB_SPIN_CAP) { atomicAdd(&(bar)[XB_TMO], 1u); break; } } } } while (0)

struct XcdBarrier {
    unsigned* bar; unsigned x;
    volatile LAS unsigned* st;
};

__device__ __forceinline__ XcdBarrier xcd_barrier_post(unsigned* bar, volatile LAS unsigned* st) {
    XcdBarrier b; b.bar = bar; b.x = xb_xcc_id(); b.st = st;
    if (threadIdx.x == 0) (void)xb_add(&bar[XB_XCNT(b.x)], 1u);
    return b;
}
__device__ __forceinline__ void xcd_barrier_complete(unsigned* bar, unsigned x, unsigned& nloc, unsigned& nx) {
    const unsigned G = gridDim.x * gridDim.y * gridDim.z;
    unsigned sum, cnt, mine, sp = 0u;
    for (;;) {
        sum = 0u; cnt = 0u; mine = 0u;
#pragma unroll
        for (unsigned j = 0; j < 16; ++j) { const unsigned c = xb_ld(&bar[XB_XCNT(j)]); sum += c; cnt += (c > 0u) ? 1u : 0u; mine = (j == x) ? c : mine; }
        if (sum == G) break;
        __builtin_amdgcn_s_sleep(1);
        if ((++sp & 255u) == 0u) { if (xb_ld(&bar[XB_TMO])) break; if (sp > XB_SPIN_CAP) { atomicAdd(&bar[XB_TMO], 1u); break; } }
    }
    nloc = mine > 0u ? mine : 1u; nx = cnt > 0u ? cnt : 1u;
}

__device__ __forceinline__ void xcd_barrier(const XcdBarrier& b) {
    asm volatile("s_waitcnt vmcnt(0)" ::: "memory");
    __syncthreads();
    if (threadIdx.x == 0) {
        unsigned* bar = b.bar;
        __builtin_amdgcn_s_waitcnt(0);
        unsigned nloc = b.st[0], nx = b.st[1];
        if (nloc == 0u) { xcd_barrier_complete(bar, b.x, nloc, nx); b.st[0] = nloc; b.st[1] = nx; }
        const unsigned old = xb_add(&bar[XB_XSUB(b.x)], 1u);
        const unsigned gen = old / nloc;
        if (old + 1u == (gen + 1u) * nloc) {
            __builtin_amdgcn_fence(__ATOMIC_RELEASE, "agent");
            asm volatile("s_waitcnt vmcnt(0)" ::: "memory");
            const unsigned og = xb_add(&bar[XB_TOP], 1u);
            const unsigned tg = og / nx;
            if (og + 1u == (tg + 1u) * nx) xb_add(&bar[XB_TOPGEN], 1u);
            else XB_SPIN(xb_ld(&bar[XB_TOPGEN]) == tg, bar);
            __builtin_amdgcn_fence(__ATOMIC_ACQUIRE, "agent");
            xb_add(&bar[XB_XGEN(b.x)], 1u);
            asm volatile("s_waitcnt vmcnt(0)" ::: "memory");
        } else {
            XB_SPIN(xb_ld(&bar[XB_XGEN(b.x)]) == gen, bar);
            __builtin_amdgcn_fence(__ATOMIC_ACQUIRE, "agent");
            asm volatile("s_waitcnt vmcnt(0)" ::: "memory");
        }
    }
    __syncthreads();
}


struct Frame {
    LAS unsigned char* lds;
    volatile LAS unsigned* MISC;
    unsigned* ctl;
    int tid, lane, wave, vcu, G;
};
__device__ __forceinline__ float wave_sum(float v) {
#pragma unroll
    for (int o = 1; o < 64; o <<= 1) v += __shfl_xor(v, o);
    return v;
}
struct P0Item { const float* W; const float* kscale; bf16* WT; int ldw, K, src_col0, dst_row0, k0; bool valid, fp8; };
__device__ __forceinline__ void p0_load(const P0Item& d, f32x4 (&v)[8], int lane) {
    const int l8 = lane & 7, r8 = lane >> 3;
#pragma unroll
    for (int i = 0; i < 8; ++i) v[i] = __builtin_nontemporal_load((const f32x4*)(d.W + (size_t)(d.k0 + 8 * i + r8) * d.ldw + d.src_col0 + 4 * l8));
}
__device__ __forceinline__ void p0_finish(const P0Item& d, f32x4 (&v)[8], LAS float* scr, int lane) {
    if (!d.valid) return;
    const int l8 = lane & 7, r8 = lane >> 3;
    if (d.kscale) {
#pragma unroll
        for (int i = 0; i < 8; ++i) v[i] = v[i] * d.kscale[d.k0 + 8 * i + r8]; }
#pragma unroll
    for (int i = 0; i < 8; ++i) { LAS float* p = scr + (8 * i + r8) * 33 + 4 * l8; p[0] = v[i][0]; p[1] = v[i][1]; p[2] = v[i][2]; p[3] = v[i][3]; }
    LDS_WAIT(); asm volatile("" ::: "memory");
    if (d.fp8) {
        const int c = lane & 3;
#pragma unroll
        for (int j = 0; j < 2; ++j) { const int n = (lane >> 2) + 16 * j; const LAS float* s = scr + (16 * c) * 33 + n; v4u o;
            o.x = pg8::pack4_fp8(32.f * s[0 * 33], 32.f * s[1 * 33], 32.f * s[2 * 33], 32.f * s[3 * 33]); o.y = pg8::pack4_fp8(32.f * s[4 * 33], 32.f * s[5 * 33], 32.f * s[6 * 33], 32.f * s[7 * 33]);
            o.z = pg8::pack4_fp8(32.f * s[8 * 33], 32.f * s[9 * 33], 32.f * s[10 * 33], 32.f * s[11 * 33]); o.w = pg8::pack4_fp8(32.f * s[12 * 33], 32.f * s[13 * 33], 32.f * s[14 * 33], 32.f * s[15 * 33]);
            __builtin_nontemporal_store(o, (v4u*)((unsigned char*)d.WT + (size_t)(d.dst_row0 + n) * d.K + d.k0 + 16 * c)); }
    } else {
    const int c = lane & 7;
#pragma unroll
    for (int j = 0; j < 4; ++j) { const int n = (lane >> 3) + 8 * j; const LAS float* s = scr + (8 * c) * 33 + n;
        v4u o; o.x = pk2(s[0 * 33], s[1 * 33]); o.y = pk2(s[2 * 33], s[3 * 33]); o.z = pk2(s[4 * 33], s[5 * 33]); o.w = pk2(s[6 * 33], s[7 * 33]);
        *(v4u*)(d.WT + (size_t)(d.dst_row0 + n) * d.K + d.k0 + 8 * c) = o; }
    }
    LDS_WAIT(); asm volatile("" ::: "memory");
}
__device__ __forceinline__ int src_in(int g) {
    const int tile = g >> 3, gi = g & 7;
    if (tile == 0) return 32 * gi;
    if (tile == 1) return 384 + 32 * gi;
    if (tile == 2) { if (gi < 2) return 256 + 32 * gi; if (gi == 2) return 640; if (gi == 3) return -1; if (gi < 6) return 320 + 32 * (gi - 4); if (gi == 6) return 672; return -1; }
    if (tile <= 10) { const int base = tile <= 6 ? 704 : 1728, i = tile - (tile <= 6 ? 3 : 7), gh = gi & 3; return base + (2 * i + (gh >> 1)) * 128 + (gi >= 4 ? 64 : 0) + 32 * (gh & 1); }
    if (tile <= 14) return 2752 + 256 * (tile - 11) + 32 * gi;
    if (tile <= 22) return (gi < 4 ? 3776 : 5824) + 128 * (tile - 15) + 32 * (gi & 3);
    return 4800 + 256 * (tile - 23) + 32 * gi;
}
__device__ __forceinline__ int src_uq(int g) {
    const int tile = g >> 3, gi = g & 7;
    if (tile < 4) return (2 * tile + (gi >> 2)) * 192 + 32 * (gi & 3);
    return (4 * (tile - 4) + (gi & 3)) * 192 + (gi < 4 ? 128 : 160);
}
__device__ __forceinline__ int src_up(int g) { const int tile = g >> 3, gi = g & 7; return (gi < 4 ? 0 : 1024) + 128 * tile + 32 * (gi & 3); }

struct Args { const float* in[18]; float* out; unsigned char* ws; int ph_lo, ph_hi; };
typedef const __attribute__((address_space(4))) Args* KArgsP;

constexpr int P0_SMALL_ITEMS = 16 * 216 + 6 * 48 + 4 * 64 + 16 * 32, P0_ALL_ITEMS = P0_SMALL_ITEMS + 32 * 16 * 64 + 32 * 16 * 32;
__device__ __forceinline__ void p0_prologue(Frame& F, KArgsP A, int it_lo, int it_hi, int gw, int NGW, bool do_x) {
    const float* x = A->in[0]; const int* positions = (const int*)A->in[1];
    const float *w_in = A->in[2], *q_norm_g = A->in[3], *w_uq = A->in[4], *kv_norm_g = A->in[5], *w_ukv = A->in[6], *w_o = A->in[7], *w_up = A->in[12], *w_down = A->in[14];
    unsigned char* ws = A->ws;
    LAS float* scr = (LAS float*)(F.lds + RING_OFF + F.wave * 16384);
    constexpr int I_IN = 16 * 216, I_UQ = 6 * 48, I_UKV = 4 * 64, I_O = 16 * 32, I_UP = 32 * 16 * 64, I_DN = 32 * 16 * 32;
    constexpr int NITEMS = I_IN + I_UQ + I_UKV + I_O + I_UP + I_DN;
    auto desc = [&](int it) -> P0Item {
        P0Item d; d.valid = it < it_hi; d.fp8 = false; d.kscale = nullptr; d.W = w_in; d.WT = (bf16*)(ws + WS_WIN); d.ldw = 6848; d.K = 1024; d.src_col0 = 0; d.dst_row0 = 0; d.k0 = 0;
        if (!d.valid) return d;
        int r = it;
        if (r < I_IN) { const int kb = r / 216, g = r % 216, sc = src_in(g); d.valid = sc >= 0; d.src_col0 = sc < 0 ? 0 : sc; d.dst_row0 = 32 * g; d.k0 = 64 * kb; return d; } r -= I_IN;
        if (r < I_UQ) { const int kb = r / 48, g = r % 48; d.W = w_uq; d.WT = (bf16*)(ws + WS_WUQ); d.ldw = 1536; d.K = 384; d.src_col0 = src_uq(g); d.dst_row0 = 32 * g; d.k0 = 64 * kb; d.kscale = q_norm_g; return d; } r -= I_UQ;
        if (r < I_UKV) { const int kb = r / 64, g = r % 64; d.W = w_ukv; d.WT = (bf16*)(ws + WS_WUKV); d.ldw = 2048; d.K = 256; d.src_col0 = 32 * g; d.dst_row0 = 32 * g; d.k0 = 64 * kb; d.kscale = kv_norm_g; return d; } r -= I_UKV;
        if (r < I_O) { const int kb = r / 32, g = r % 32; d.W = w_o; d.WT = (bf16*)(ws + WS_WO); d.ldw = 1024; d.src_col0 = 32 * g; d.dst_row0 = 32 * g; d.k0 = 64 * kb; return d; } r -= I_O;
        if (r < I_UP) { const int e = r / 1024, q = r % 1024, kb = q / 64, g = q % 64;
            d.W = w_up + (size_t)e * 1024 * 2048; d.WT = (bf16*)(ws + WS_WUP + (size_t)e * 2048 * 1024); d.fp8 = true; d.ldw = 2048; d.src_col0 = src_up(g); d.dst_row0 = 32 * g; d.k0 = 64 * kb; return d; } r -= I_UP;
        { const int e = r / 512, q = r % 512, kb = q / 32, g = q % 32;
            d.W = w_down + (size_t)e * 1024 * 1024; d.WT = (bf16*)(ws + WS_WDN + (size_t)e * 1024 * 1024); d.fp8 = true; d.ldw = 1024; d.src_col0 = 32 * g; d.dst_row0 = 32 * g; d.k0 = 64 * kb; return d; }
    };
    static_assert(NITEMS == P0_ALL_ITEMS, "item count");
    { f32x4 v0[8], v1[8], v2[8], v3[8]; const int i0 = it_lo + gw; P0Item d0 = desc(i0), d1 = desc(i0 + NGW), d2 = desc(i0 + 2 * NGW), d3;
      p0_load(d0, v0, F.lane); p0_load(d1, v1, F.lane); p0_load(d2, v2, F.lane);
      for (int it = i0; it < it_hi; it += 4 * NGW) {
          d3 = desc(it + 3 * NGW); p0_load(d3, v3, F.lane); p0_finish(d0, v0, scr, F.lane);
          d0 = desc(it + 4 * NGW); p0_load(d0, v0, F.lane); p0_finish(d1, v1, scr, F.lane);
          d1 = desc(it + 5 * NGW); p0_load(d1, v1, F.lane); p0_finish(d2, v2, scr, F.lane);
          d2 = desc(it + 6 * NGW); p0_load(d2, v2, F.lane); p0_finish(d3, v3, scr, F.lane); } }
    if (!do_x) return;
    bf16* XB = (bf16*)(ws + WS_XB);
    float *cosM = (float*)(ws + WS_COSM), *sinM = (float*)(ws + WS_SINM), *cosR = (float*)(ws + WS_COSR), *sinR = (float*)(ws + WS_SINR);
    const double rfR = exp2(-(double)F.lane * (13.287712379549449 / 63.0)) * 0.15915494309189535, rfM = exp2(-(double)(F.lane & 31) * (13.287712379549449 / 32.0)) * 0.15915494309189535;
    for (int m0 = gw; m0 < T; m0 += 4 * NGW) {
        f32x4 xv[4][4]; int pp[4];
#pragma unroll
        for (int k = 0; k < 4; ++k) { const int mk = m0 + k * NGW < T ? m0 + k * NGW : m0; const f32x4* xr = (const f32x4*)(x + (size_t)mk * DM) + F.lane; pp[k] = positions[mk];
#pragma unroll
            for (int j = 0; j < 4; ++j) xv[k][j] = __builtin_nontemporal_load(xr + 64 * j); }
#pragma unroll
        for (int k = 0; k < 4; ++k) { const int m = m0 + k * NGW; if (m < T) {
        unsigned long long* o8 = (unsigned long long*)(XB + (size_t)m * DM) + F.lane;
#pragma unroll
        for (int j = 0; j < 4; ++j) { const f32x4 v = xv[k][j]; o8[64 * j] = (unsigned long long)pk2(v.x, v.y) | ((unsigned long long)pk2(v.z, v.w) << 32); }
        const double pos = (double)pp[k];
        { const int i = F.lane;
          const double rev = pos * rfR; const float fr = (float)(rev - rint(rev));
          cosR[(size_t)m * 64 + i] = __builtin_amdgcn_cosf(fr); sinR[(size_t)m * 64 + i] = __builtin_amdgcn_sinf(fr); }
        if (F.lane < 32) { const int i = F.lane;
          const double rev = pos * rfM; const float fr = (float)(rev - rint(rev));
          cosM[(size_t)m * 32 + i] = __builtin_amdgcn_cosf(fr); sinM[(size_t)m * 32 + i] = __builtin_amdgcn_sinf(fr); }
        } }
    }
}

__device__ __forceinline__ void p6_reduce16(const float (&p)[16], int lane, float& out) {
    float q8[8], q4[4], q2[2];
    { const bool up = (lane & 32) != 0;
#pragma unroll
      for (int k = 0; k < 8; ++k) { const float snd = up ? p[k] : p[k + 8], keep = up ? p[k + 8] : p[k]; q8[k] = keep + __shfl_xor(snd, 32); } }
    { const bool up = (lane & 16) != 0;
#pragma unroll
      for (int k = 0; k < 4; ++k) { const float snd = up ? q8[k] : q8[k + 4], keep = up ? q8[k + 4] : q8[k]; q4[k] = keep + __shfl_xor(snd, 16); } }
    { const bool up = (lane & 8) != 0;
#pragma unroll
      for (int k = 0; k < 2; ++k) { const float snd = up ? q4[k] : q4[k + 2], keep = up ? q4[k + 2] : q4[k]; q2[k] = keep + __shfl_xor(snd, 8); } }
    { const bool up = (lane & 4) != 0; const float snd = up ? q2[0] : q2[1], keep = up ? q2[1] : q2[0]; out = keep + __shfl_xor(snd, 4); }
    out += __shfl_xor(out, 2); out += __shfl_xor(out, 1);
}
__device__ __forceinline__ void p6_ln1_router(Frame& F, KArgsP A, bool dummy) {
    unsigned char* ws = A->ws;
    const float *ln_g = A->in[8], *ln_b = A->in[9], *w_router = A->in[10], *b_router = A->in[11];
    const bf16* Y = (const bf16*)(ws + WS_Y); bf16* H1B = (bf16*)(ws + WS_H1B);
    int* TOPI = (int*)(ws + WS_TOPI); float* GATE = (float*)(ws + WS_GATE); int* RANK = (int*)(ws + (dummy ? WS_XS : WS_RANK)); unsigned* CNT = F.ctl + (dummy ? CW_CNT + 128 : CW_CNT);
    LAS float* WR = (LAS float*)(F.lds);
    LAS int* le = (LAS int*)(F.lds + RT_LIST_OFF);
    LAS float* wsc = (LAS float*)(F.lds + RT_SCR_OFF) + F.wave * 96;
    for (int i = F.tid; i < 1024 * 8; i += NWAVES * 64) { const int c = i >> 3, q = i & 7; *(LAS f32x4*)(WR + c * 36 + 4 * q) = *(const f32x4*)(w_router + (size_t)c * 32 + 4 * q); }
    const int lane0 = F.lane;
    const float ebv[2] = {b_router[lane0 >> 2], b_router[16 + (lane0 >> 2)]};
    __syncthreads();
    for (int unit = F.vcu; unit < T / 64; unit += F.G) {
        const int t0 = unit * 64;
#pragma unroll 1
        for (int pr = 0; pr < 4; ++pr) {
            const int tl0 = F.wave + 16 * pr;
            int lane = lane0; asm volatile("" : "+v"(lane));
            float v[2][16];
#pragma unroll
            for (int u = 0; u < 2; ++u)
                { const bf16* yp = Y + (size_t)(t0 + tl0 + 8 * u) * DM + lane;
#pragma unroll
                  for (int i = 0; i < 16; ++i) v[u][i] = __uint_as_float((unsigned)__builtin_nontemporal_load(yp + 64 * i) << 16); }
            float lgv[16], lbv[16];
#pragma unroll
            for (int i = 0; i < 16; ++i) { lgv[i] = ln_g[lane + 64 * i]; lbv[i] = ln_b[lane + 64 * i]; }
            __builtin_amdgcn_sched_barrier(0);
            float s[2] = {0.f, 0.f};
#pragma unroll
            for (int i = 0; i < 16; ++i) { s[0] += v[0][i]; s[1] += v[1][i]; }
#pragma unroll
            for (int o = 1; o < 64; o <<= 1) { s[0] += __shfl_xor(s[0], o); s[1] += __shfl_xor(s[1], o); }
            const float mean0 = s[0] * (1.0f / DM), mean1 = s[1] * (1.0f / DM); float q0 = 0.f, q1 = 0.f;
#pragma unroll
            for (int i = 0; i < 16; ++i) { v[0][i] -= mean0; v[1][i] -= mean1; q0 += v[0][i] * v[0][i]; q1 += v[1][i] * v[1][i]; }
#pragma unroll
            for (int o = 1; o < 64; o <<= 1) { q0 += __shfl_xor(q0, o); q1 += __shfl_xor(q1, o); }
            const float rstd0 = 1.0f / sqrtf(q0 * (1.0f / DM) + LN_EPS), rstd1 = 1.0f / sqrtf(q1 * (1.0f / DM) + LN_EPS);
            const size_t ta = (size_t)(t0 + tl0) * DM + lane, tb = ta + 8 * DM;
            bf16* hba = H1B + ta; bf16* hbb = H1B + tb;
#pragma unroll
            for (int i = 0; i < 16; ++i) { const float gg = lgv[i], bb = lbv[i]; v[0][i] = v[0][i] * rstd0 * gg + bb; v[1][i] = v[1][i] * rstd1 * gg + bb; }
#pragma unroll
            for (int i = 0; i < 16; ++i) { hba[64 * i] = (bf16)f2bf(v[0][i]); hbb[64 * i] = (bf16)f2bf(v[1][i]); }
            const LAS float* wrp = WR + lane * 36;
#pragma unroll
            for (int eh = 0; eh < 2; ++eh) {
                float p0[16], p1[16];
#pragma unroll
                for (int e = 0; e < 16; ++e) { p0[e] = 0.f; p1[e] = 0.f; }
#pragma unroll
                for (int i = 0; i < 16; ++i) { const float ha = v[0][i], hb = v[1][i];
#pragma unroll
                    for (int q = 0; q < 4; ++q) { const f32x4 w = *(const LAS f32x4*)(wrp + i * (64 * 36) + 16 * eh + 4 * q);
                        p0[4 * q + 0] += ha * w[0]; p0[4 * q + 1] += ha * w[1]; p0[4 * q + 2] += ha * w[2]; p0[4 * q + 3] += ha * w[3];
                        p1[4 * q + 0] += hb * w[0]; p1[4 * q + 1] += hb * w[1]; p1[4 * q + 2] += hb * w[2]; p1[4 * q + 3] += hb * w[3]; }
                    asm volatile("" ::: "memory"); }
                float l0, l1; p6_reduce16(p0, lane, l0); p6_reduce16(p1, lane, l1);
                const int e = 16 * eh + (lane >> 2); const float eb = ebv[eh];
                if ((lane & 3) == 0) { wsc[e] = l0 + eb; wsc[48 + e] = l1 + eb; } }
            LDS_WAIT(); asm volatile("" ::: "memory");
            { const int e = lane & 31; const LAS float* wt = wsc + 48 * (lane >> 5); const float mine = wt[e]; int rk = 0;
#pragma unroll
              for (int q = 0; q < 8; ++q) { const f32x4 a = *(const LAS f32x4*)(wt + 4 * q);
#pragma unroll
                  for (int j = 0; j < 4; ++j) rk += (int)(a[j] > mine) | ((int)(a[j] == mine) & (int)(4 * q + j < e)); }
              LDS_WAIT(); asm volatile("" ::: "memory");
              if (rk < 4) { ((LAS float*)wt)[32 + rk] = mine; ((LAS int*)wt)[36 + rk] = e; } }
            LDS_WAIT(); asm volatile("" ::: "memory");
            if (lane < 2) { const LAS float* w = wsc + 48 * lane; const f32x4 tv = *(const LAS f32x4*)(w + 32); const i32x4 ti = *(const LAS i32x4*)(w + 36);
                const float e1 = __expf(tv[1] - tv[0]), e2 = __expf(tv[2] - tv[0]), e3 = __expf(tv[3] - tv[0]), inv = 1.0f / (1.0f + e1 + e2 + e3);
                const int tl = tl0 + 8 * lane; const size_t t = (size_t)(t0 + tl);
                *(i32x4*)(TOPI + t * 4) = ti; *(float4*)(GATE + t * 4) = make_float4(inv, e1 * inv, e2 * inv, e3 * inv);
                *(LAS i32x4*)(le + tl * 4) = ti; }
            LDS_WAIT(); asm volatile("" ::: "memory");
        }
        __syncthreads();
        { LAS int* cw = (LAS int*)(F.lds + RT_SCR_OFF);
          int my_e = -1, my_r = 0;
          if (F.tid < 256) { my_e = le[F.tid];
              for (int e = 0; e < 32; ++e) { const unsigned long long m = __ballot(my_e == e);
                  if (my_e == e) my_r = __popcll(m & ((1ull << F.lane) - 1ull));
                  if (F.lane == e) cw[F.wave * 32 + e] = __popcll(m); } }
          __syncthreads();
          if (F.tid < 32) { const int c0 = cw[F.tid], c1 = cw[32 + F.tid], c2 = cw[64 + F.tid], c3 = cw[96 + F.tid], tot = c0 + c1 + c2 + c3;
              int base = 0; if (tot) base = (int)atomicAdd(CNT + F.tid, (unsigned)tot);
              cw[128 + F.tid] = base; }
          __syncthreads();
          if (F.tid < 256) { int r = cw[128 + my_e] + my_r;
              for (int w = 0; w < F.wave; ++w) r += cw[w * 32 + my_e];
              RANK[(size_t)t0 * 4 + F.tid] = r; }
          __syncthreads(); }
    }
}
__device__ __forceinline__ void p7_dispatch(Frame& F, KArgsP A) {
    unsigned char* ws = A->ws;
    LAS int* pstart = (LAS int*)(F.lds);
    int* ROWTOK = (int*)(ws + WS_ROWTOK);
    if (F.wave == 0) {
        const int e = F.lane & 31, cnt = (int)F.ctl[CW_CNT + e], tl = (cnt + 255) >> 8; int inc = tl; int* TILE_E = (int*)(ws + WS_TILEE);
#pragma unroll
        for (int o = 1; o < 32; o <<= 1) { const int v = __shfl_up(inc, o); if (e >= o) inc += v; }
        const int excl = inc - tl;
        if (F.lane < 32) { pstart[e] = excl * 256; pstart[32 + e] = cnt;
            if (blockIdx.x == 0) { for (int i = 0; i < tl; ++i) TILE_E[excl + i] = e; if (e == 31) F.ctl[CW_NMT] = (unsigned)inc; } } }
    __syncthreads();
    if (blockIdx.x < NE) { const int e = blockIdx.x, c = pstart[32 + e], p0 = pstart[e] + c, p1 = pstart[e] + ((c + 255) & ~255);
        for (int r = p0 + F.tid; r < p1; r += NWAVES * 64) ROWTOK[r] = 0; }
    const int* TOPI = (const int*)(ws + WS_TOPI); const int* RANK = (const int*)(ws + WS_RANK); int* SLOT = (int*)(ws + WS_SLOT);
    const int gt = F.vcu * (NWAVES * 64) + F.tid, NGT = F.G * NWAVES * 64;
    for (int a = gt; a < T * 4; a += NGT) { const int dest = pstart[TOPI[a]] + RANK[a]; SLOT[a] = dest; ROWTOK[dest] = a >> 2; }
    const bf16* H1B = (const bf16*)(ws + WS_H1B); unsigned char* H1Q = ws + WS_H1Q;
    const int gw = F.vcu * NWAVES + F.wave, NGW = F.G * NWAVES;
#define BLO(x) __uint_as_float((x) << 16)
#define BHI(x) __uint_as_float((x) & 0xffff0000u)
    for (int t = gw; t < T; t += 4 * NGW) {
        v4u s0[4], s1[4];
#pragma unroll
        for (int k = 0; k < 4; ++k) { const int tk = t + k * NGW < T ? t + k * NGW : t; const v4u* src = (const v4u*)(H1B + (size_t)tk * DM) + 2 * F.lane; s0[k] = src[0]; s1[k] = src[1]; }
#pragma unroll
        for (int k = 0; k < 4; ++k) { const int tk = t + k * NGW; if (tk < T) {
            v4u o; o.x = pg8::pack4_fp8(BLO(s0[k].x), BHI(s0[k].x), BLO(s0[k].y), BHI(s0[k].y)); o.y = pg8::pack4_fp8(BLO(s0[k].z), BHI(s0[k].z), BLO(s0[k].w), BHI(s0[k].w));
            o.z = pg8::pack4_fp8(BLO(s1[k].x), BHI(s1[k].x), BLO(s1[k].y), BHI(s1[k].y)); o.w = pg8::pack4_fp8(BLO(s1[k].z), BHI(s1[k].z), BLO(s1[k].w), BHI(s1[k].w));
            ((v4u*)(H1Q + (size_t)tk * DM))[F.lane] = o; } } }
#undef BLO
#undef BHI
    __syncthreads();
}
__device__ __forceinline__ void p10_combine_ln2(Frame& F, KArgsP A) {
    unsigned char* ws = A->ws;
    const float *ln_g = A->in[16], *ln_b = A->in[17];
    const bf16* H1B = (const bf16*)(ws + WS_H1B); const float* GATE = (const float*)(ws + WS_GATE); const int* SLOT = (const int*)(ws + WS_SLOT); const unsigned char* YS = ws + WS_YS;
    const int gw = F.vcu * NWAVES + F.wave, NGW = F.G * NWAVES;
    f32x4 lg[4], lb[4];
#pragma unroll
    for (int j = 0; j < 4; ++j) { lg[j] = ((const f32x4*)ln_g)[F.lane + 64 * j]; lb[j] = ((const f32x4*)ln_b)[F.lane + 64 * j]; }
    if (gw >= T) return;
#define P10_DATA(N, tt) do { const int sk_[4] = {sl##N.x, sl##N.y, sl##N.z, sl##N.w}; gt##N = *(const float4*)(GATE + (size_t)(tt) * 4); _Pragma("unroll") for (int j = 0; j < 4; ++j) { hh##N[j] = __builtin_nontemporal_load((const v2u*)(H1B + (size_t)(tt) * DM) + F.lane + 64 * j); \
        _Pragma("unroll") for (int k = 0; k < 4; ++k) y##N[j][k] = __builtin_nontemporal_load((const unsigned*)(YS + (size_t)sk_[k] * DM) + F.lane + 64 * j); } } while (0)
#define P10_STEP(tt, C, N) do { const int t0_ = (tt), t1_ = t0_ + NGW < T ? t0_ + NGW : t0_, t2_ = t0_ + 2 * NGW < T ? t0_ + 2 * NGW : t0_; \
        { const int4 slc_ = sl##C; (void)slc_; } sl##C = *(const int4*)(SLOT + (size_t)t2_ * 4); P10_DATA(N, t1_); __builtin_amdgcn_sched_barrier(0);     \
        const float gk[4] = {gt##C.x, gt##C.y, gt##C.z, gt##C.w}; f32x4 v[4]; float s = 0.f; \
        _Pragma("unroll") for (int j = 0; j < 4; ++j) { { const v2u hh = hh##C[j]; \
              v[j].x = DN_ALPHA * __uint_as_float(hh.x << 16); v[j].y = DN_ALPHA * __uint_as_float(hh.x & 0xffff0000u); v[j].z = DN_ALPHA * __uint_as_float(hh.y << 16); v[j].w = DN_ALPHA * __uint_as_float(hh.y & 0xffff0000u); } \
            _Pragma("unroll") for (int k = 0; k < 4; ++k) { const int y = (int)y##C[j][k]; const float gq = gk[k] * 0.0625f;     \
                v[j].x += gq * __builtin_amdgcn_cvt_f32_fp8(y, 0); v[j].y += gq * __builtin_amdgcn_cvt_f32_fp8(y, 1); v[j].z += gq * __builtin_amdgcn_cvt_f32_fp8(y, 2); v[j].w += gq * __builtin_amdgcn_cvt_f32_fp8(y, 3); } \
            s += (v[j].x + v[j].y) + (v[j].z + v[j].w); } \
        const float mean = wave_sum(s) * (1.0f / DM); float s2 = 0.f; \
        _Pragma("unroll") for (int j = 0; j < 4; ++j) { v[j] = v[j] - mean; s2 += (v[j].x * v[j].x + v[j].y * v[j].y) + (v[j].z * v[j].z + v[j].w * v[j].w); } \
        const float rstd = 1.0f / sqrtf(wave_sum(s2) * (1.0f / DM) + LN_EPS); \
        _Pragma("unroll") for (int j = 0; j < 4; ++j) { v[j] = v[j] * rstd * lg[j] + lb[j]; __builtin_nontemporal_store(v[j], (f32x4*)(A->out + (size_t)t0_ * DM) + F.lane + 64 * j); } __builtin_amdgcn_sched_barrier(0); } while (0)
    float4 gt0, gt1; int4 sl0, sl1; v2u hh0[4], hh1[4]; unsigned y0[4][4], y1[4][4];
    sl0 = *(const int4*)(SLOT + (size_t)gw * 4); { const int t1 = gw + NGW < T ? gw + NGW : gw; sl1 = *(const int4*)(SLOT + (size_t)t1 * 4); }
    P10_DATA(0, gw);
    for (int t = gw; t < T; t += 2 * NGW) {
        P10_STEP(t, 0, 1);
        P10_STEP(t + NGW < T ? t + NGW : t, 1, 0);
    }
#undef P10_STEP
#undef P10_DATA
}

#ifndef DBG_SUB
#define DBG_SUB 2
#endif
#ifndef DBG_STAGE
#define DBG_STAGE 0
#endif
#if DBG_STAGE == 2
#define PH_MASK 0x403
#elif DBG_STAGE == 3
#define PH_MASK 0x407
#elif DBG_STAGE == 4
#define PH_MASK 0x41f
#elif DBG_STAGE == 6
#define PH_MASK 0x40f
#elif DBG_STAGE == 7
#define PH_MASK 0x407
#elif DBG_STAGE == 8
#define PH_MASK 0x407
#endif
__device__ __forceinline__ void dbg_copy_out(Frame& F, KArgsP A) {
    unsigned char* ws = A->ws; const int gw = F.vcu * NWAVES + F.wave, NGW = F.G * NWAVES;
    for (int t = gw; t < T; t += NGW) {
#pragma unroll
        for (int j = 0; j < 4; ++j) { f32x4 v;
#if DBG_STAGE == 1
            v = ((const f32x4*)((const float*)(ws + WS_Y) + (size_t)t * DM))[F.lane + 64 * j];
#elif DBG_STAGE == 2
            { const v2u y = ((const v2u*)((const bf16*)(ws + WS_RQ) + (size_t)t * DM))[F.lane + 64 * j]; v.x = __uint_as_float(y.x << 16); v.y = __uint_as_float(y.x & 0xffff0000u); v.z = __uint_as_float(y.y << 16); v.w = __uint_as_float(y.y & 0xffff0000u); }
#elif DBG_STAGE == 3
            { const v2u y = ((const v2u*)((const bf16*)(ws + WS_KN) + (size_t)t * DM))[F.lane + 64 * j]; v.x = __uint_as_float(y.x << 16); v.y = __uint_as_float(y.x & 0xffff0000u); v.z = __uint_as_float(y.y << 16); v.w = __uint_as_float(y.y & 0xffff0000u); }
#elif DBG_STAGE == 4 || DBG_STAGE == 6
            { const v2u y = ((const v2u*)((const bf16*)(ws + WS_MIX) + (size_t)t * DM))[F.lane + 64 * j]; v.x = __uint_as_float(y.x << 16); v.y = __uint_as_float(y.x & 0xffff0000u); v.z = __uint_as_float(y.y << 16); v.w = __uint_as_float(y.y & 0xffff0000u); }
#elif DBG_STAGE == 7
            { const v2u y = ((const v2u*)((const bf16*)(ws + WS_QB) + (size_t)t * 1536))[F.lane + 64 * j]; v.x = __uint_as_float(y.x << 16); v.y = __uint_as_float(y.x & 0xffff0000u); v.z = __uint_as_float(y.y << 16); v.w = __uint_as_float(y.y & 0xffff0000u); }
#elif DBG_STAGE == 8
            { const int c4 = F.lane + 64 * j; const bf16* src = c4 < 16 ? (const bf16*)(ws + WS_KR) + (size_t)t * 64 + 4 * c4 : (c4 < 128 ? (const bf16*)(ws + WS_VB) : (const bf16*)(ws + WS_GM)) + (size_t)t * DM + 4 * c4;
              v2u y = *(const v2u*)src; if ((c4 < 16 ? 0 : (c4 < 128 ? 1 : 2)) != DBG_SUB) y = (v2u){0u, 0u}; v.x = __uint_as_float(y.x << 16); v.y = __uint_as_float(y.x & 0xffff0000u); v.z = __uint_as_float(y.y << 16); v.w = __uint_as_float(y.y & 0xffff0000u); }
#elif DBG_STAGE == 5
            v = ((const f32x4*)((const float*)(ws + WS_H1) + (size_t)t * DM))[F.lane + 64 * j];
#else
            v = (f32x4){0.f, 0.f, 0.f, 0.f};
#endif
            ((f32x4*)(A->out + (size_t)t * DM))[F.lane + 64 * j] = v; }
    }
}

__global__ void __launch_bounds__(NWAVES * 64, 2) mk_fwd(Args args) {
    extern __shared__ __attribute__((aligned(16))) unsigned char lds[];
    typedef const __attribute__((address_space(4))) Args* KArgs;
#define PHASE_FRAME() Frame F; { int t_ = threadIdx.x; asm volatile("" : "+v"(t_)); F.lds = (LAS unsigned char*)lds; F.MISC = (volatile LAS unsigned*)(F.lds + MISC_OFF); F.tid = t_; F.lane = t_ & 63; \
        F.wave = __builtin_amdgcn_readfirstlane(t_ >> 6); F.G = gridDim.x; const int bx_ = blockIdx.x; F.vcu = (F.G % 8 == 0) ? (bx_ % 8) * (F.G / 8) + bx_ / 8 : bx_; } \
    KArgs ap_ = (KArgs)__builtin_amdgcn_kernarg_segment_ptr(); asm volatile("" : "+s"(ap_)); unsigned char* ws = ap_->ws; F.ctl = (unsigned*)(ws + WS_CTL); unsigned char* w_ = ws; (void)w_
    LAS unsigned char* lds3 = (LAS unsigned char*)lds;
    { const int t0_ = threadIdx.x; for (int u = t0_; u < (LDS_BYTES - MISC_OFF) / 4; u += NWAVES * 64) ((LAS unsigned*)(lds3 + MISC_OFF))[u] = 0u; }
    __syncthreads();
    unsigned* ctl0 = (unsigned*)(args.ws + WS_CTL);
    XcdBarrier bar; bar.bar = ctl0 + CW_BAR; bar.x = 0; bar.st = nullptr;
    if (!MK_PER_PHASE) bar = xcd_barrier_post(ctl0 + CW_BAR, (volatile LAS unsigned*)(lds3 + MISC_OFF) + 8);
#define GRID_BAR() do { if (MK_PER_PHASE) { if (threadIdx.x == 0) __hip_atomic_store(bar.bar - CW_BAR + CW_TMO, 0xBADBA0u, RLX_AGENT); } else { xcd_barrier(bar); } } while (0)
    const int lo = args.ph_lo, hi = args.ph_hi;
#ifndef PH_MASK
#define PH_MASK 0x7ff
#endif
#define IN(k) (((PH_MASK >> (k)) & 1) && lo <= (k) && (k) < hi)
#define BOTH(k) (IN(k) && IN((k) + 1))
#ifndef DUP_P0
#define DUP_P0 0
#endif
#ifndef DUP_P1
#define DUP_P1 0
#endif
#ifndef DUP_P2
#define DUP_P2 0
#endif
#ifndef DUP_P3
#define DUP_P3 0
#endif
#ifndef ATT_PROBE_VAR
#define ATT_PROBE_VAR 0
#endif
#ifndef DUP_P4
#define DUP_P4 0
#endif
#ifndef DUP_P5
#define DUP_P5 0
#endif
#ifndef DUP_P6
#define DUP_P6 0
#endif
#ifndef DUP_P7
#define DUP_P7 0
#endif
#ifndef DUP_P8
#define DUP_P8 0
#endif
#ifndef DUP_P9
#define DUP_P9 0
#endif
#ifndef DUP_P10
#define DUP_P10 0
#endif
#define PHASE_IF_0(k) if (IN(k))
#define PHASE_IF_1(k) _Pragma("unroll") for (int rep_ = 0; rep_ < 2; ++rep_) if (IN(k))
#define PHASE_CAT(a, b) a##b
#define PHASE_SEL(d) PHASE_CAT(PHASE_IF_, d)
#define PHASE_IF(k) PHASE_SEL(DUP_P##k)(k)
#if DUP_P4
#define PROBE_FIRST_4 (rep_ == 0)
#else
#define PROBE_FIRST_4 false
#endif
#if DUP_P6
#define PROBE_FIRST_6 (rep_ == 0)
#else
#define PROBE_FIRST_6 false
#endif
    typedef pg8::bf16_t b16;
#define WSP(T_, off) ((T_*)(w_ + (off)))
#define PHASE_WS() PHASE_FRAME()

#define NBG_OF(G_) 0
    PHASE_IF(0) { { PHASE_FRAME(); p0_prologue(F, ap_, 0, NBG_OF(F.G) ? P0_SMALL_ITEMS : P0_ALL_ITEMS, F.vcu * NWAVES + F.wave, F.G * NWAVES, true); } __syncthreads(); if (BOTH(0)) GRID_BAR(); }

    PHASE_IF(1) {
        PHASE_WS();
        const int nbg = NBG_OF(F.G), nmain = F.G - nbg;
        if ((int)blockIdx.x >= nmain) { p0_prologue(F, ap_, P0_SMALL_ITEMS, P0_ALL_ITEMS, ((int)blockIdx.x - nmain) * NWAVES + F.wave, nbg * NWAVES, false); __syncthreads(); } else {
        pg8::Gemm g{WSP(b16, WS_XB), WSP(b16, WS_WIN), T, NP1, DM}; pg8::StaticOrder S; S.init(T, NP1, nmain, (int)blockIdx.x);
        pg8::EpiProj E{WSP(b16, WS_CQ), WSP(b16, WS_CKV), WSP(b16, WS_KR), WSP(b16, WS_RQ), WSP(b16, WS_RK), WSP(b16, WS_RV), WSP(b16, WS_GR), WSP(b16, WS_GM),
                       WSP(float, WS_SSQQ), WSP(float, WS_SSQKV), WSP(float, WS_COSM), WSP(float, WS_SINM), WSP(float, WS_COSR), WSP(float, WS_SINR)};
        pg8::gemm_phase<pg8::EpiProj, pg8::StaticOrder, true, true>(F.lds + RING_OFF, g, S, E); }
        if (BOTH(1)) GRID_BAR();
    }
    PHASE_IF(2) {
        PHASE_WS();
        { pg8::Gemm g{WSP(b16, WS_CQ), WSP(b16, WS_WUQ), T, 1536, 384}; pg8::StaticOrder S; S.init(T, 1536, F.G, (int)blockIdx.x);
          pg8::EpiQ E{{WSP(b16, WS_QB), WSP(float, WS_SSQQ)}, {WSP(b16, WS_QB), WSP(float, WS_SSQQ), WSP(float, WS_COSM), WSP(float, WS_SINM)}};
          pg8::gemm_phase<pg8::EpiQ, pg8::StaticOrder, true, true>(F.lds + RING_OFF, g, S, E); }
        { pg8::Gemm g{WSP(b16, WS_CKV), WSP(b16, WS_WUKV), T, 2048, 256}; pg8::StaticOrder S; S.init(T, 2048, F.G, (int)blockIdx.x);
          pg8::EpiKV E{WSP(b16, WS_KN), WSP(b16, WS_VB), WSP(float, WS_SSQKV)};
          pg8::gemm_phase<pg8::EpiKV, pg8::StaticOrder, true, true>(F.lds + RING_OFF, g, S, E); }
        ret::u_phase(WSP(b16, WS_RK), WSP(b16, WS_RV), WSP(b16, WS_UT), F.vcu, F.G, (LAS char*)F.lds);
        if (BOTH(2)) GRID_BAR();
    }
    PHASE_IF(3) {
        PHASE_WS();
        ret::scan_all(WSP(b16, WS_UT), WSP(b16, WS_RT), F.vcu * (NWAVES * 64) + F.tid, F.G * NWAVES * 64);
        const att::Tensors X{WSP(b16, WS_QB), WSP(b16, WS_KN), WSP(b16, WS_KR), WSP(b16, WS_VB), WSP(b16, WS_GM), WSP(b16, WS_MIX)};
#if DUP_P3
        if (rep_ == 0) att::attn_phase<ATT_PROBE_VAR>(X, (LAS char*)F.lds, F.vcu, F.G); else
#endif
        att::attn_phase<0>(X, (LAS char*)F.lds, F.vcu, F.G);
        if (BOTH(3)) GRID_BAR();
    }
    PHASE_IF(4) {
        PHASE_WS();
        ret::out_phase(WSP(b16, WS_RQ), WSP(b16, WS_RK), WSP(b16, WS_RV), WSP(b16, WS_RT), WSP(b16, WS_GR), WSP(b16, WS_MIX), PROBE_FIRST_4 ? WSP(b16, WS_UT) : WSP(b16, WS_MIX), F.vcu, F.G, (LAS char*)F.lds);
        if (BOTH(4)) GRID_BAR();
    }
    PHASE_IF(5) {
        PHASE_WS();
        pg8::Gemm g{WSP(b16, WS_MIX), WSP(b16, WS_WO), T, DM, DM}; pg8::StaticOrder S; S.init(T, DM, F.G, (int)blockIdx.x);
        pg8::EpiY E{ap_->in[0], WSP(b16, WS_Y), DN_ALPHA};
        pg8::gemm_phase<pg8::EpiY, pg8::StaticOrder, true, true>(F.lds + RING_OFF, g, S, E);
        if (BOTH(5)) GRID_BAR();
    }
    PHASE_IF(6) { { PHASE_FRAME(); p6_ln1_router(F, ap_, PROBE_FIRST_6); } if (BOTH(6)) GRID_BAR(); }
    PHASE_IF(7) { { PHASE_FRAME(); p7_dispatch(F, ap_); } if (BOTH(7)) GRID_BAR(); }
    PHASE_IF(8) {
        PHASE_WS();
        const int nmt = (int)__hip_atomic_load(F.ctl + CW_NMT, RLX_AGENT);
        pg8::Gemm g{WSP(b16, WS_H1Q), WSP(b16, WS_WUP), nmt * 256, 2048, DM / 2};
        pg8::GroupedOrder S; S.init(nmt * 256, 2048, F.G, (int)blockIdx.x); S.tile_e = WSP(const int, WS_TILEE);
        LAS int* tokl = (LAS int*)(F.lds + RING_BYTES);
        { const int* ROWTOK = WSP(const int, WS_ROWTOK); pg8::Unit uu;
          for (int i = 0; S.next(i, uu); ++i) if (F.tid < 256) tokl[i * 256 + F.tid] = ROWTOK[uu.pm * 256 + F.tid];
          __syncthreads(); }
        pg8::EpiSwiglu E{WSP(unsigned char, WS_A2), ap_->in[13]};
        pg8::gemm_phase<pg8::EpiSwiglu, pg8::GroupedOrder, true, true, true, true>(F.lds + RING_OFF, g, S, E, tokl);
        if (BOTH(8)) GRID_BAR();
    }
    PHASE_IF(9) {
        PHASE_WS();
        const int nmt = (int)__hip_atomic_load(F.ctl + CW_NMT, RLX_AGENT);
        pg8::Gemm g{WSP(b16, WS_A2), WSP(b16, WS_WDN), nmt * 256, DM, DM / 2}; pg8::GroupedOrder S; S.init(nmt * 256, DM, F.G, (int)blockIdx.x); S.tile_e = WSP(const int, WS_TILEE);
        pg8::EpiDown E{WSP(unsigned char, WS_YS), ap_->in[15]};
        pg8::gemm_phase<pg8::EpiDown, pg8::GroupedOrder, true, true, true>(F.lds + RING_OFF, g, S, E);
        if (BOTH(9)) GRID_BAR();
    }
    PHASE_IF(10) { PHASE_FRAME();
#if DBG_STAGE
        dbg_copy_out(F, ap_);
#else
        p10_combine_ln2(F, ap_);
#endif
    }
#undef IN
#undef BOTH
#undef GRID_BAR
}

extern "C" void kernel_launch(void* const* d_in, const int* in_sizes, int n_in, void* d_out, int out_size, void* d_ws, size_t ws_size, hipStream_t stream) {
    static int grid = 0;
    if (grid == 0) {
        if (n_in != 18 || in_sizes[0] != T * DM || out_size != T * DM || ws_size < WS_END) { fprintf(stderr, "kernel_launch: unexpected shapes (n_in %d, in0 %d, out %d, ws %zu)\n", n_in, n_in > 0 ? in_sizes[0] : -1, out_size, ws_size); grid = -1; return; }
        int dev = 0, cus = 0, per_cu = 0;
        if (hipGetDevice(&dev) != hipSuccess || hipDeviceGetAttribute(&cus, hipDeviceAttributeMultiprocessorCount, dev) != hipSuccess) { grid = -1; return; }
        if (hipFuncSetAttribute((const void*)mk_fwd, hipFuncAttributeMaxDynamicSharedMemorySize, LDS_BYTES) != hipSuccess) { fprintf(stderr, "kernel_launch: hipFuncSetAttribute failed\n"); grid = -1; return; }
        if (hipOccupancyMaxActiveBlocksPerMultiprocessor(&per_cu, (const void*)mk_fwd, NWAVES * 64, LDS_BYTES) != hipSuccess || per_cu < 1) { fprintf(stderr, "kernel_launch: occupancy query reports %d\n", per_cu); }
        (void)hipGetLastError();
        grid = cus;
    }
    if (grid < 0) return;
    if (hipMemsetAsync((char*)d_ws + WS_CTL, 0, CTL_ZERO_BYTES, stream) != hipSuccess) return;
    Args a{};
    for (int i = 0; i < 18; ++i) a.in[i] = (const float*)d_in[i];
    a.out = (float*)d_out; a.ws = (unsigned char*)d_ws;
#if MK_PER_PHASE
    for (int p = 0; p < NPH; ++p) { a.ph_lo = p; a.ph_hi = p + 1; hipLaunchKernelGGL(mk_fwd, dim3(grid), dim3(NWAVES * 64), LDS_BYTES, stream, a); }
#else
    a.ph_lo = 0; a.ph_hi = NPH;
    hipLaunchKernelGGL(mk_fwd, dim3(grid), dim3(NWAVES * 64), LDS_BYTES, stream, a);
#endif
}
```

```cpp
#include <hip/hip_runtime.h>
#include <cstdio>
#include <cstdint>
#define LAS __attribute__((address_space(3)))
namespace pg8 {
#define PG8_LAS __attribute__((address_space(3)))
typedef unsigned short bf16_t;
typedef short bf16x8 __attribute__((ext_vector_type(8)));
typedef float f32x4 __attribute__((ext_vector_type(4)));
typedef unsigned u32x4 __attribute__((ext_vector_type(4)));
typedef int i32x4 __attribute__((ext_vector_type(4)));
typedef int i32x8 __attribute__((ext_vector_type(8)));
constexpr int BM = 256, BK = 64, HALF = 128, HTB = HALF * BK * 2  , STAGE_BYTES = 8 * HTB, NXCD = 8, WGM = 4;

__host__ __device__ __forceinline__ int lds_byte(int r, int c) { const int st = (r >> 4) * 2 + (c >> 5), rr = r & 15, cc = c & 31, ob = rr * 64 + cc * 2; return st * 1024 + (ob ^ (((ob >> 9) & 1) << 5)); }
__host__ __device__ __forceinline__ void stage_rc(int b, int& R, int& C) { const int st = b / 1024, sb = b % 1024, swz = sb ^ (((sb >> 9) & 1) << 5); R = (st >> 1) * 16 + swz / 64; C = (st & 1) * 32 + (swz % 64) / 2; }
__host__ __device__ __forceinline__ int perm32(int rho) { const int n = rho >> 4, i = rho & 15; return 8 * (i >> 2) + 4 * n + (i & 3); }

struct Unit { int pm, pn, pb, e; };
struct Gemm { const bf16_t* A; const bf16_t* Bt; int M, N, K; };

struct StaticOrder {
    int nM, nN, nwg, G, c;
    __host__ __device__ void init(int M, int N, int G_, int c_) { nM = M / BM; nN = N / BM; nwg = nM * nN; G = G_; c = c_; }
    __host__ __device__ __forceinline__ bool next(int i, Unit& u) const {
        const long L = (long)i * G + c; if (L >= nwg) return false;
        int wgid = (int)L; { const int q = nwg / NXCD, r = nwg % NXCD, xcd = wgid % NXCD, off = wgid / NXCD; wgid = (xcd < r ? xcd * (q + 1) : r * (q + 1) + (xcd - r) * q) + off; }
        const int nig = WGM * nN, gid = wgid / nig, fm = gid * WGM, gsz = (nM - fm) < WGM ? (nM - fm) : WGM;
        u.pm = fm + ((wgid % nig) % gsz); u.pn = (wgid % nig) / gsz; u.pb = u.pn; u.e = 0; return true;
    }
    __device__ __forceinline__ void a_ready(const Unit&) const {}
    __device__ __forceinline__ void done(const Unit&) const {}
};

struct GroupedOrder : StaticOrder {
    const int* tile_e;
    __device__ __forceinline__ bool next(int i, Unit& u) const {
        if (!StaticOrder::next(i, u)) return false;
        u.e = __builtin_amdgcn_readfirstlane(tile_e[u.pm]); u.pb = u.e * nN + u.pn; return true;
    }
};

typedef unsigned u32x2 __attribute__((ext_vector_type(2)));
typedef float f32x2_t __attribute__((ext_vector_type(2))); typedef __bf16 bf16x2_t __attribute__((ext_vector_type(2)));
__device__ __forceinline__ unsigned cvt_pk_bf16(float lo, float hi) { const f32x2_t v = {lo, hi}; const bf16x2_t b = __builtin_convertvector(v, bf16x2_t); return __builtin_bit_cast(unsigned, b); }
__device__ __forceinline__ u32x4 pack8(const f32x4 a, const f32x4 b) { u32x4 w; w.x = cvt_pk_bf16(a[0], a[1]); w.y = cvt_pk_bf16(a[2], a[3]); w.z = cvt_pk_bf16(b[0], b[1]); w.w = cvt_pk_bf16(b[2], b[3]); return w; }
__device__ __forceinline__ unsigned pack4_fp8(float a, float b, float c, float d) { int w = 0; w = __builtin_amdgcn_cvt_pk_fp8_f32(a, b, w, false); w = __builtin_amdgcn_cvt_pk_fp8_f32(c, d, w, true); return (unsigned)w; }
__device__ __forceinline__ float sigm(float x) { return __builtin_amdgcn_rcpf(1.0f + __expf(-x)); }
__device__ __forceinline__ f32x4 sigm4(const f32x4 x) { f32x4 e = x * -1.4426950408889634f;
#pragma unroll
    for (int j = 0; j < 4; ++j) e[j] = __builtin_amdgcn_exp2f(e[j]);
    e = e + 1.0f;
#pragma unroll
    for (int j = 0; j < 4; ++j) e[j] = __builtin_amdgcn_rcpf(e[j]);
    return e; }

#define PG8_DPP_F(v, ctrl) __uint_as_float((unsigned)__builtin_amdgcn_update_dpp(0, (int)__float_as_uint(v), ctrl, 0xF, 0xF, true))
__device__ __forceinline__ float swap_sum16(float v) { const auto r = __builtin_amdgcn_permlane16_swap(__float_as_uint(v), __float_as_uint(v), false, false); return __uint_as_float(r[0]) + __uint_as_float(r[1]); }
__device__ __forceinline__ float swap_sum32(float v) { const auto r = __builtin_amdgcn_permlane32_swap(__float_as_uint(v), __float_as_uint(v), false, false); return __uint_as_float(r[0]) + __uint_as_float(r[1]); }
__device__ __forceinline__ float wave_allsum(float v) {
    v += PG8_DPP_F(v, 0xB1); v += PG8_DPP_F(v, 0x4E);
    v += PG8_DPP_F(v, 0x124); v += PG8_DPP_F(v, 0x128);
    return swap_sum32(swap_sum16(v)); }
#define EPI_PIN4(a, b, c, d) asm volatile("" : "+v"(a), "+v"(b), "+v"(c), "+v"(d) :: "memory")
struct EpiProj {
    static constexpr bool PERM = true, AFTER_DRAIN = false, HAS_INIT = false;
    bf16_t *CQ, *CKV, *KR, *RQ, *RK, *RV, *GR, *GM; float *ssq_q, *ssq_kv;
    const float *cosM, *sinM, *cosR, *sinR;
    __device__ __forceinline__ void operator()(const f32x4 (&acc)[2][2][4][2], const Unit& u, int wr, int wc, int fr, int fq) const {
        asm volatile("" : "+v"(fr), "+v"(fq));
        const int pn = u.pn, row0 = u.pm * BM + wr * 64 + fr, c8 = wc * 32 + 8 * fq;
        if (pn <= 1) {
            bf16_t* O = pn == 0 ? CQ : CKV; const int ld = pn == 0 ? 384 : 256; float* ssq = pn == 0 ? ssq_q + wc : ssq_kv + wc; const int sst = pn == 0 ? 8 : 4;
#pragma unroll
            for (int ai = 0; ai < 2; ++ai)
#pragma unroll
                for (int m = 0; m < 4; ++m) { const int row = row0 + ai * HALF + m * 16; float s = 0.f;
#pragma unroll
                    for (int bj = 0; bj < 2; ++bj) { const f32x4 v0 = acc[ai][bj][m][0], v1 = acc[ai][bj][m][1];
                        s += (v0[0] * v0[0] + v0[1] * v0[1]) + (v0[2] * v0[2] + v0[3] * v0[3]) + (v1[0] * v1[0] + v1[1] * v1[1]) + (v1[2] * v1[2] + v1[3] * v1[3]);
                        *(u32x4*)(O + (size_t)row * ld + bj * HALF + c8) = pack8(v0, v1); }
                    s = swap_sum32(swap_sum16(s));
                    if (fq == 0) ssq[(size_t)row * sst] = s; }
        } else if (pn == 2) {
            if (wc < 2) {
#pragma unroll
                for (int ai = 0; ai < 2; ++ai)
#pragma unroll
                    for (int m = 0; m < 4; ++m) { const int row = row0 + ai * HALF + m * 16; float s = 0.f;
#pragma unroll
                        for (int bj = 0; bj < 2; ++bj) { const f32x4 v0 = acc[ai][bj][m][0], v1 = acc[ai][bj][m][1];
                            s += (v0[0] * v0[0] + v0[1] * v0[1]) + (v0[2] * v0[2] + v0[3] * v0[3]) + (v1[0] * v1[0] + v1[1] * v1[1]) + (v1[2] * v1[2] + v1[3] * v1[3]);
                            *(u32x4*)(CQ + (size_t)row * 384 + 256 + bj * 64 + c8) = pack8(v0, v1); }
                        s = swap_sum32(swap_sum16(s));
                        if (fq == 0) ssq_q[(size_t)row * 8 + 4 + wc] = s; }
            } else if (wc == 2) {
                const int f0 = 8 * fq;
#pragma unroll
                for (int ai = 0; ai < 2; ++ai)
#pragma unroll
                    for (int m = 0; m < 4; ++m) { const int row = row0 + ai * HALF + m * 16;
                        const f32x4 c0 = *(const f32x4*)(cosM + (size_t)row * 32 + f0), c1 = *(const f32x4*)(cosM + (size_t)row * 32 + f0 + 4);
                        const f32x4 s0 = *(const f32x4*)(sinM + (size_t)row * 32 + f0), s1 = *(const f32x4*)(sinM + (size_t)row * 32 + f0 + 4);
                        f32x4 a0 = acc[ai][0][m][0], a1 = acc[ai][0][m][1], b0 = acc[ai][1][m][0], b1 = acc[ai][1][m][1]; EPI_PIN4(a0, a1, b0, b1);
                        *(u32x4*)(KR + (size_t)row * 64 + f0) = pack8(a0 * c0 - b0 * s0, a1 * c1 - b1 * s1);
                        *(u32x4*)(KR + (size_t)row * 64 + 32 + f0) = pack8(b0 * c0 + a0 * s0, b1 * c1 + a1 * s1); }
            }
        } else if (pn <= 10) {
            const bool isk = pn >= 7; bf16_t* O = isk ? RK : RQ; const float sc = isk ? 0.08838834764831845f : 1.0f;
            const int head = 2 * (pn - (isk ? 7 : 3)) + (wc >> 1), f0 = 32 * (wc & 1) + 8 * fq;
            f32x4 tc[2][2], ts[2][2];
            { const size_t o = (size_t)row0 * 64 + f0; tc[0][0] = *(const f32x4*)(cosR + o); tc[0][1] = *(const f32x4*)(cosR + o + 4); ts[0][0] = *(const f32x4*)(sinR + o); ts[0][1] = *(const f32x4*)(sinR + o + 4); }
#pragma unroll
            for (int g = 0; g < 8; ++g) { const int row = row0 + (g >> 2) * HALF + (g & 3) * 16, ai = g >> 2, m = g & 3, cu = g & 1, nx = cu ^ 1;
                if (g < 7) { const size_t o = (size_t)(row0 + ((g + 1) >> 2) * HALF + ((g + 1) & 3) * 16) * 64 + f0;
                    tc[nx][0] = *(const f32x4*)(cosR + o); tc[nx][1] = *(const f32x4*)(cosR + o + 4); ts[nx][0] = *(const f32x4*)(sinR + o); ts[nx][1] = *(const f32x4*)(sinR + o + 4); }
                const f32x4 c0 = tc[cu][0] * sc, c1 = tc[cu][1] * sc, s0 = ts[cu][0] * sc, s1 = ts[cu][1] * sc;
                f32x4 a0 = acc[ai][0][m][0], a1 = acc[ai][0][m][1], b0 = acc[ai][1][m][0], b1 = acc[ai][1][m][1]; EPI_PIN4(a0, a1, b0, b1);
                *(u32x4*)(O + (size_t)row * 1024 + head * 128 + f0) = pack8(a0 * c0 - b0 * s0, a1 * c1 - b1 * s1);
                *(u32x4*)(O + (size_t)row * 1024 + head * 128 + 64 + f0) = pack8(b0 * c0 + a0 * s0, b1 * c1 + a1 * s1); }
        } else if (pn <= 14) {
            const int cb = 256 * (pn - 11) + c8;
#pragma unroll
            for (int ai = 0; ai < 2; ++ai)
#pragma unroll
                for (int m = 0; m < 4; ++m) { const int row = row0 + ai * HALF + m * 16;
#pragma unroll
                    for (int bj = 0; bj < 2; ++bj) *(u32x4*)(RV + (size_t)row * 1024 + cb + bj * HALF) = pack8(acc[ai][bj][m][0], acc[ai][bj][m][1]); }
        } else if (pn <= 22) {
            const int cb = 128 * (pn - 15) + c8;
#pragma unroll
            for (int ai = 0; ai < 2; ++ai)
#pragma unroll
                for (int m = 0; m < 4; ++m) { const int row = row0 + ai * HALF + m * 16;
                    f32x4 g0 = acc[ai][0][m][0], g1 = acc[ai][0][m][1], t0 = acc[ai][1][m][0], t1 = acc[ai][1][m][1]; EPI_PIN4(g0, g1, t0, t1);
                    f32x4 eg0 = g0 * -1.4426950408889634f, eg1 = g1 * -1.4426950408889634f, et0 = t0 * -1.4426950408889634f, et1 = t1 * -1.4426950408889634f;
#pragma unroll
                    for (int j = 0; j < 4; ++j) { eg0[j] = __builtin_amdgcn_exp2f(eg0[j]); eg1[j] = __builtin_amdgcn_exp2f(eg1[j]); et0[j] = __builtin_amdgcn_exp2f(et0[j]); et1[j] = __builtin_amdgcn_exp2f(et1[j]); }
                    f32x4 d0 = (eg0 + 1.0f) * (et0 + 1.0f), d1 = (eg1 + 1.0f) * (et1 + 1.0f);
#pragma unroll
                    for (int j = 0; j < 4; ++j) { d0[j] = __builtin_amdgcn_rcpf(d0[j]); d1[j] = __builtin_amdgcn_rcpf(d1[j]); }
                    *(u32x4*)(GR + (size_t)row * 1024 + cb) = pack8(g0 * d0, g1 * d1); }
        } else {
            const int cb = 256 * (pn - 23) + c8;
#pragma unroll
            for (int ai = 0; ai < 2; ++ai)
#pragma unroll
                for (int m = 0; m < 4; ++m) { const int row = row0 + ai * HALF + m * 16;
#pragma unroll
                    for (int bj = 0; bj < 2; ++bj) *(u32x4*)(GM + (size_t)row * 1024 + cb + bj * HALF) = pack8(sigm4(acc[ai][bj][m][0]), sigm4(acc[ai][bj][m][1]));
                    }
        }
    }
};

struct EpiQn {
    static constexpr bool PERM = true, AFTER_DRAIN = false, HAS_INIT = false;
    bf16_t* Q; const float* ssq;
    __device__ __forceinline__ void operator()(const f32x4 (&acc)[2][2][4][2], const Unit& u, int wr, int wc, int fr, int fq) const {
        asm volatile("" : "+v"(fr), "+v"(fq));
        const int pn = u.pn, row0 = u.pm * BM + wr * 64 + fr, c8 = wc * 32 + 8 * fq;
        float rsv[8];
#pragma unroll
        for (int g = 0; g < 8; ++g) { const int row = row0 + (g >> 2) * HALF + (g & 3) * 16;
            const f32x4 sA = *(const f32x4*)(ssq + (size_t)row * 8); const float sB = ssq[(size_t)row * 8 + 4], sC = ssq[(size_t)row * 8 + 5];
            rsv[g] = __builtin_amdgcn_rsqf((((sA[0] + sA[1]) + (sA[2] + sA[3])) + (sB + sC)) * (1.0f / 384.0f) + 1e-6f); }
        asm volatile("" ::: "memory");
#pragma unroll
        for (int ai = 0; ai < 2; ++ai)
#pragma unroll
            for (int m = 0; m < 4; ++m) { const int row = row0 + ai * HALF + m * 16; const float rs = rsv[ai * 4 + m];
#pragma unroll
                for (int bj = 0; bj < 2; ++bj) *(u32x4*)(Q + (size_t)row * 1536 + (2 * pn + bj) * 192 + c8) = pack8(acc[ai][bj][m][0] * rs, acc[ai][bj][m][1] * rs); }
    }
};
struct EpiQr {
    static constexpr bool PERM = true, AFTER_DRAIN = false, HAS_INIT = false;
    bf16_t* Q; const float* ssq; const float *cosM, *sinM;
    __device__ __forceinline__ void operator()(const f32x4 (&acc)[2][2][4][2], const Unit& u, int wr, int wc, int fr, int fq) const {
        asm volatile("" : "+v"(fr), "+v"(fq));
        const int row0 = u.pm * BM + wr * 64 + fr, head = 4 * u.pn + wc, f0 = 8 * fq;
        f32x4 tc[2][2], ts[2][2], sq[2]; float sq2[2][2];
#define QR_LOAD(slot, rw) do { const size_t o = (size_t)(rw) * 32 + f0; tc[slot][0] = *(const f32x4*)(cosM + o); tc[slot][1] = *(const f32x4*)(cosM + o + 4); ts[slot][0] = *(const f32x4*)(sinM + o); ts[slot][1] = *(const f32x4*)(sinM + o + 4); \
            sq[slot] = *(const f32x4*)(ssq + (size_t)(rw) * 8); sq2[slot][0] = ssq[(size_t)(rw) * 8 + 4]; sq2[slot][1] = ssq[(size_t)(rw) * 8 + 5]; } while (0)
        QR_LOAD(0, row0);
#pragma unroll
        for (int g = 0; g < 8; ++g) { const int row = row0 + (g >> 2) * HALF + (g & 3) * 16, ai = g >> 2, m = g & 3, cu = g & 1, nx = cu ^ 1;
            if (g < 7) QR_LOAD(nx, row0 + ((g + 1) >> 2) * HALF + ((g + 1) & 3) * 16);
            f32x4 a0 = acc[ai][0][m][0], a1 = acc[ai][0][m][1], b0 = acc[ai][1][m][0], b1 = acc[ai][1][m][1]; EPI_PIN4(a0, a1, b0, b1);
            const float rs = __builtin_amdgcn_rsqf((((sq[cu][0] + sq[cu][1]) + (sq[cu][2] + sq[cu][3])) + (sq2[cu][0] + sq2[cu][1])) * (1.0f / 384.0f) + 1e-6f);
            const f32x4 c0 = tc[cu][0] * rs, c1 = tc[cu][1] * rs, s0 = ts[cu][0] * rs, s1 = ts[cu][1] * rs;
            *(u32x4*)(Q + (size_t)row * 1536 + head * 192 + 128 + f0) = pack8(a0 * c0 - b0 * s0, a1 * c1 - b1 * s1);
            *(u32x4*)(Q + (size_t)row * 1536 + head * 192 + 160 + f0) = pack8(b0 * c0 + a0 * s0, b1 * c1 + a1 * s1); }
#undef QR_LOAD
    }
};
struct EpiQ {
    static constexpr bool PERM = true, AFTER_DRAIN = false, HAS_INIT = false;
    EpiQn n; EpiQr r;
    __device__ __forceinline__ void operator()(const f32x4 (&acc)[2][2][4][2], const Unit& u, int wr, int wc, int fr, int fq) const {
        if (u.pn < 4) n(acc, u, wr, wc, fr, fq); else { Unit v = u; v.pn = u.pn - 4; r(acc, v, wr, wc, fr, fq); }
    }
};
struct EpiKV {
    static constexpr bool PERM = true, AFTER_DRAIN = false, HAS_INIT = false;
    bf16_t *KN, *V; const float* ssq;
    __device__ __forceinline__ void operator()(const f32x4 (&acc)[2][2][4][2], const Unit& u, int wr, int wc, int fr, int fq) const {
        asm volatile("" : "+v"(fr), "+v"(fq));
        const int row0 = u.pm * BM + wr * 64 + fr, cb = u.pn * 128 + wc * 32 + 8 * fq;
        float rsv[8];
#pragma unroll
        for (int g = 0; g < 8; ++g) { const f32x4 sA = *(const f32x4*)(ssq + (size_t)(row0 + (g >> 2) * HALF + (g & 3) * 16) * 4);
            rsv[g] = __builtin_amdgcn_rsqf(((sA[0] + sA[1]) + (sA[2] + sA[3])) * (1.0f / 256.0f) + 1e-6f); }
        asm volatile("" ::: "memory");
#pragma unroll
        for (int ai = 0; ai < 2; ++ai)
#pragma unroll
            for (int m = 0; m < 4; ++m) { const int row = row0 + ai * HALF + m * 16; const float rs = rsv[ai * 4 + m];
                *(u32x4*)(KN + (size_t)row * 1024 + cb) = pack8(acc[ai][0][m][0] * rs, acc[ai][0][m][1] * rs);
                *(u32x4*)(V + (size_t)row * 1024 + cb) = pack8(acc[ai][1][m][0] * rs, acc[ai][1][m][1] * rs); }
    }
};
struct EpiY {
    static constexpr bool PERM = true, AFTER_DRAIN = false, HAS_INIT = false;
    const bf16_t* XB; bf16_t* Y; float alpha;
    __device__ __forceinline__ void operator()(const f32x4 (&acc)[2][2][4][2], const Unit& u, int wr, int wc, int fr, int fq) const {
        asm volatile("" : "+v"(fr), "+v"(fq));
        const int row0 = u.pm * BM + wr * 64 + fr, col0 = u.pn * BM + wc * 32 + 8 * fq;
        u32x4 xv[4][2];
#define EPIY_LOAD(slot, g_) do { const size_t o_ = (size_t)(row0 + ((g_) >> 2) * HALF + ((g_) & 3) * 16) * 1024 + col0; \
        _Pragma("unroll") for (int bj = 0; bj < 2; ++bj) xv[slot][bj] = __builtin_nontemporal_load((const u32x4*)(XB + o_ + bj * HALF)); } while (0)
#define EPIY_LO(w_) __uint_as_float((w_) << 16)
#define EPIY_HI(w_) __uint_as_float((w_) & 0xffff0000u)
        EPIY_LOAD(0, 0); EPIY_LOAD(1, 1); EPIY_LOAD(2, 2);
#pragma unroll
        for (int g = 0; g < 8; ++g) { const int ai = g >> 2, m = g & 3, cu = g & 3; const size_t off = (size_t)(row0 + ai * HALF + m * 16) * 1024 + col0;
            if (g < 5) EPIY_LOAD((g + 3) & 3, g + 3);
            f32x4 a0 = acc[ai][0][m][0], a1 = acc[ai][0][m][1], b0 = acc[ai][1][m][0], b1 = acc[ai][1][m][1]; EPI_PIN4(a0, a1, b0, b1);
            const u32x4 xa = xv[cu][0], xb = xv[cu][1];
            const f32x4 xa0 = {EPIY_LO(xa.x), EPIY_HI(xa.x), EPIY_LO(xa.y), EPIY_HI(xa.y)}, xa1 = {EPIY_LO(xa.z), EPIY_HI(xa.z), EPIY_LO(xa.w), EPIY_HI(xa.w)};
            const f32x4 xb0 = {EPIY_LO(xb.x), EPIY_HI(xb.x), EPIY_LO(xb.y), EPIY_HI(xb.y)}, xb1 = {EPIY_LO(xb.z), EPIY_HI(xb.z), EPIY_LO(xb.w), EPIY_HI(xb.w)};
            *(u32x4*)(Y + off) = pack8(xa0 * alpha + a0, xa1 * alpha + a1);
            *(u32x4*)(Y + off + HALF) = pack8(xb0 * alpha + b0, xb1 * alpha + b1); }
#undef EPIY_LOAD
#undef EPIY_LO
#undef EPIY_HI
    }
};
struct EpiSwiglu {
    static constexpr bool PERM = true, AFTER_DRAIN = false, HAS_INIT = true; static constexpr int SCW = 122;
    unsigned char* A2; const float* b_up;
    __device__ __forceinline__ void load_init(f32x4 (&ini)[2][2], const Unit& u, int wc, int fq) const {
        const float* bg = b_up + (size_t)u.e * 2048 + u.pn * 128 + wc * 32 + 8 * fq;
        ini[0][0] = *(const f32x4*)bg; ini[0][1] = *(const f32x4*)(bg + 4); ini[1][0] = *(const f32x4*)(bg + 1024) + 1.0f; ini[1][1] = *(const f32x4*)(bg + 1028) + 1.0f;
    }
    __device__ __forceinline__ void operator()(const f32x4 (&acc)[2][2][4][2], const Unit& u, int wr, int wc, int fr, int fq) const {
        asm volatile("" : "+v"(fr), "+v"(fq));
        const int row0 = u.pm * BM + wr * 64 + fr, cb = u.pn * 128 + wc * 32 + 8 * fq;
#pragma unroll
        for (int ai = 0; ai < 2; ++ai)
#pragma unroll
            for (int m = 0; m < 4; ++m) { const int row = row0 + ai * HALF + m * 16;
                f32x4 g0 = acc[ai][0][m][0], g1 = acc[ai][0][m][1], l0 = acc[ai][1][m][0], l1 = acc[ai][1][m][1]; EPI_PIN4(g0, g1, l0, l1);
#pragma unroll
                for (int j = 0; j < 4; ++j) { g0[j] = __builtin_amdgcn_fmed3f(g0[j], -3.0e38f, 7.0f); g1[j] = __builtin_amdgcn_fmed3f(g1[j], -3.0e38f, 7.0f);
                    l0[j] = __builtin_amdgcn_fmed3f(l0[j], -6.0f, 8.0f); l1[j] = __builtin_amdgcn_fmed3f(l1[j], -6.0f, 8.0f); }
                const f32x4 t0 = g0 * -2.4554669595930156f, t1 = g1 * -2.4554669595930156f;
                f32x4 d0, d1;
#pragma unroll
                for (int j = 0; j < 4; ++j) { d0[j] = __builtin_amdgcn_exp2f(t0[j]); d1[j] = __builtin_amdgcn_exp2f(t1[j]); }
                d0 = d0 + 1.0f; d1 = d1 + 1.0f;
                f32x4 r0, r1;
#pragma unroll
                for (int j = 0; j < 4; ++j) { r0[j] = __builtin_amdgcn_rcpf(d0[j]); r1[j] = __builtin_amdgcn_rcpf(d1[j]); }
                const f32x4 o0 = (g0 * l0) * r0, o1 = (g1 * l1) * r1;
                u32x2 w; w.x = pack4_fp8(o0[0], o0[1], o0[2], o0[3]); w.y = pack4_fp8(o1[0], o1[1], o1[2], o1[3]);
                *(u32x2*)(A2 + (size_t)row * 1024 + cb) = w; }
    }
};
struct EpiDown {
    static constexpr bool PERM = true, AFTER_DRAIN = false, HAS_INIT = true; static constexpr int SCW = 126;
    unsigned char* YS; const float* b_down;
    __device__ __forceinline__ void load_init(f32x4 (&ini)[2][2], const Unit& u, int wc, int fq) const {
        const float* bb = b_down + (size_t)u.e * 1024 + u.pn * BM + wc * 32 + 8 * fq;
#pragma unroll
        for (int bj = 0; bj < 2; ++bj) { ini[bj][0] = *(const f32x4*)(bb + bj * HALF) * 16.0f; ini[bj][1] = *(const f32x4*)(bb + bj * HALF + 4) * 16.0f; }
    }
    __device__ __forceinline__ void operator()(const f32x4 (&acc)[2][2][4][2], const Unit& u, int wr, int wc, int fr, int fq) const {
        asm volatile("" : "+v"(fr), "+v"(fq));
        const int row0 = u.pm * BM + wr * 64 + fr, cb = u.pn * BM + wc * 32 + 8 * fq;
#pragma unroll
        for (int ai = 0; ai < 2; ++ai)
#pragma unroll
            for (int m = 0; m < 4; ++m) { const int row = row0 + ai * HALF + m * 16;
#pragma unroll
                for (int bj = 0; bj < 2; ++bj) { const f32x4 a = acc[ai][bj][m][0], b = acc[ai][bj][m][1];
                    u32x2 w; w.x = pack4_fp8(a[0], a[1], a[2], a[3]); w.y = pack4_fp8(b[0], b[1], b[2], b[3]);
                    *(u32x2*)(YS + (size_t)row * 1024 + cb + bj * HALF) = w; } }
    }
};
template <class Epi, class Sched, bool ALIGN_EPI = false, bool SP2 = false, bool FP8 = false, bool GATHER = false>
__device__ __forceinline__ void gemm_phase(PG8_LAS unsigned char* lds, const Gemm g, const Sched& S, const Epi& E, const PG8_LAS int* tokl = nullptr) {
    static_assert(!GATHER || SP2, "GATHER is implemented for the SP2 loop");
    int tid_ = threadIdx.x; asm volatile("" : "+v"(tid_));
    const int tid = tid_, wid = __builtin_amdgcn_readfirstlane(tid >> 6), lane = tid & 63, wr = wid >> 2, wc = wid & 3, fr = lane & 15, fq = lane >> 4;
    const int K = g.K, nt = K / BK;
    unsigned voffA, voffB;
    { int R, C; stage_rc(tid * 16, R, C); const int Rb = Epi::PERM ? ((R & ~31) + perm32(R & 31)) : R;
        voffA = (unsigned)(R * K + C) * 2u; voffB = (unsigned)(Rb * K + C) * 2u; }
    const size_t rstep = (size_t)64 * K * 2;
    unsigned gA[2][2], gN[2][2];
    int gR = 0; unsigned gC = 0; if constexpr (GATHER) { int R, C; stage_rc(tid * 16, R, C); gR = R; gC = (unsigned)C * 2u; }
#define PG8_GLOAD(dst, ui_) do { _Pragma("unroll") for (int h_ = 0; h_ < 2; ++h_) _Pragma("unroll") for (int i_ = 0; i_ < 2; ++i_) dst[h_][i_] = (unsigned)tokl[(ui_) * 256 + 128 * h_ + 64 * i_ + gR] * (unsigned)(K * 2) + gC; } while (0)
#define PG8_STA(b, h, ptr, kb, nf) do { if constexpr (GATHER) { _Pragma("unroll") for (int _i = 0; _i < 2; ++_i) \
        __builtin_amdgcn_global_load_lds((const unsigned*)((const char*)g.A + (kb) + ((nf) ? gN[h][_i] : gA[h][_i])), (PG8_LAS unsigned*)(lds + PG8_SA(b, h) + ldsw + _i * 8192), 16, 0, 0); } \
        else { PG8_STAGE(PG8_SA(b, h), ptr, voffA); } } while (0)
    const size_t kstep = (size_t)(BK * 2);
    const size_t hstep = (size_t)HALF * K * 2;
    const size_t tstep = 2 * hstep;
    const unsigned ldsw = (unsigned)wid * 1024u;
    const int aoff = lds_byte(wr * 64 + fr, fq * 8), boff = lds_byte(wc * 32 + fr, fq * 8);
#define PG8_SA(b, h) (((b) * 2 + (h)) * HTB)
#define PG8_SB(b, h) ((4 + (b) * 2 + (h)) * HTB)
#define PG8_STAGE(bufoff, gbase, voff) do { _Pragma("unroll") for (int _i = 0; _i < 2; ++_i) \
        __builtin_amdgcn_global_load_lds((const unsigned*)((const char*)(gbase) + _i * rstep + (voff)), (PG8_LAS unsigned*)(lds + (bufoff) + ldsw + _i * 8192), 16, 0, 0); } while (0)
#define PG8_LDA(dst, b, h) do { if constexpr (FP8) { _Pragma("unroll") for (int m = 0; m < 4; ++m) dst##8[m] = __builtin_shufflevector(*(const PG8_LAS i32x4*)(lds + PG8_SA(b, h) + aoff + m * 2048), *(const PG8_LAS i32x4*)(lds + PG8_SA(b, h) + aoff + m * 2048 + 1024), 0, 1, 2, 3, 4, 5, 6, 7); } \
        else { _Pragma("unroll") for (int m = 0; m < 4; ++m) _Pragma("unroll") for (int k = 0; k < 2; ++k) dst[m][k] = *(const PG8_LAS bf16x8*)(lds + PG8_SA(b, h) + aoff + m * 2048 + k * 1024); } } while (0)
#define PG8_LDB(dst, b, h) do { if constexpr (FP8) { _Pragma("unroll") for (int n = 0; n < 2; ++n) dst##8[n] = __builtin_shufflevector(*(const PG8_LAS i32x4*)(lds + PG8_SB(b, h) + boff + n * 2048), *(const PG8_LAS i32x4*)(lds + PG8_SB(b, h) + boff + n * 2048 + 1024), 0, 1, 2, 3, 4, 5, 6, 7); } \
        else { _Pragma("unroll") for (int n = 0; n < 2; ++n) _Pragma("unroll") for (int k = 0; k < 2; ++k) dst[n][k] = *(const PG8_LAS bf16x8*)(lds + PG8_SB(b, h) + boff + n * 2048 + k * 1024); } } while (0)
#define PG8_MMA(ai, bj, At, Bt) do { __builtin_amdgcn_s_setprio(1); if constexpr (FP8) { _Pragma("unroll") for (int m = 0; m < 4; ++m) _Pragma("unroll") for (int n = 0; n < 2; ++n) \
        asm volatile("v_mfma_scale_f32_16x16x128_f8f6f4 %0, %1, %2, %0, %3, %4 op_sel_hi:[0,0,0]" : "+v"(acc[ai][bj][m][n]) : "v"(Bt##8[n]), "v"(At##8[m]), "v"(sc8w), "v"(sc8a)); } \
        else { _Pragma("unroll") for (int m = 0; m < 4; ++m) _Pragma("unroll") for (int n = 0; n < 2; ++n) _Pragma("unroll") for (int k = 0; k < 2; ++k) \
        acc[ai][bj][m][n] = __builtin_amdgcn_mfma_f32_16x16x32_bf16(Bt[n][k], At[m][k], acc[ai][bj][m][n], 0, 0, 0); } __builtin_amdgcn_s_setprio(0); } while (0)
#define PG8_WAIT_V(n) asm volatile("s_waitcnt vmcnt(" #n ")" ::: "memory")
#define PG8_WAIT_L(n) asm volatile("s_waitcnt lgkmcnt(" #n ")" ::: "memory")
#define PG8_BAR __builtin_amdgcn_s_barrier()
#define PG8_SCHED __builtin_amdgcn_sched_barrier(0)
    Unit cur, nxt; int ui = 0;
    if (!S.next(0, cur)) return;
    f32x4 acc[2][2][4][2]; f32x4 ini[2][2];
    if constexpr (Epi::HAS_INIT) E.load_init(ini, cur, wc, fq);
#pragma unroll
    for (int a = 0; a < 2; ++a)
#pragma unroll
        for (int b = 0; b < 2; ++b)
#pragma unroll
            for (int m = 0; m < 4; ++m)
#pragma unroll
                for (int n = 0; n < 2; ++n) { if constexpr (Epi::HAS_INIT) acc[a][b][m][n] = ini[b][n]; else acc[a][b][m][n] = (f32x4){0.f, 0.f, 0.f, 0.f}; }
    bf16x8 At[4][2], B0[2][2], B1[2][2]; i32x8 At8[4], B08[2], B18[2];
    int sc8w = 122, sc8a = 127; if constexpr (FP8) { sc8w = Epi::SCW; asm volatile("" : "+v"(sc8w), "+v"(sc8a)); }
    const char* cA = (const char*)g.A + (size_t)cur.pm * tstep; const char* cB = (const char*)g.Bt + (size_t)cur.pb * tstep;
    S.a_ready(cur);
    if constexpr (SP2) {
        if constexpr (GATHER) { PG8_GLOAD(gA, 0); }
        PG8_STAGE(PG8_SB(0, 0), cB, voffB); PG8_STAGE(PG8_SB(0, 1), cB + hstep, voffB); PG8_STA(0, 0, cA, 0, false); PG8_STA(0, 1, cA + hstep, 0, false);
        if (wr == 1) PG8_BAR;
        PG8_WAIT_V(2); PG8_BAR;
        PG8_STAGE(PG8_SB(1, 0), cB + kstep, voffB); PG8_STA(1, 0, cA + kstep, kstep, false); PG8_STAGE(PG8_SB(1, 1), cB + hstep + kstep, voffB);
        PG8_WAIT_V(6); PG8_BAR;
    } else {
        PG8_STAGE(PG8_SB(0, 0), cB, voffB); PG8_STAGE(PG8_SA(0, 0), cA, voffA); PG8_STAGE(PG8_SB(0, 1), cB + hstep, voffB); PG8_STAGE(PG8_SA(0, 1), cA + hstep, voffA);
        if (wr == 1) PG8_BAR;
        PG8_WAIT_V(4); PG8_BAR;
        PG8_STAGE(PG8_SB(1, 0), cB + kstep, voffB); PG8_STAGE(PG8_SA(1, 0), cA + kstep, voffA); PG8_STAGE(PG8_SB(1, 1), cB + hstep + kstep, voffB);
        PG8_WAIT_V(6); PG8_BAR;
    }
    for (;;) {
        const bool has_next = S.next(ui + 1, nxt);
        if constexpr (GATHER) { if (has_next) { PG8_GLOAD(gN, ui + 1); } else { _Pragma("unroll") for (int h_ = 0; h_ < 2; ++h_) _Pragma("unroll") for (int i_ = 0; i_ < 2; ++i_) gN[h_][i_] = gA[h_][i_]; } }
        const char* nA = has_next ? (const char*)g.A + (size_t)nxt.pm * tstep : cA; const char* nB = has_next ? (const char*)g.Bt + (size_t)nxt.pb * tstep : cB;
#pragma nounroll
        for (int t = 0; t < nt; t += 2) {
            const bool last = (t == nt - 2);
            const char* a1 = cA + (size_t)(t + 1) * kstep;
            const char* a2 = last ? nA : cA + (size_t)(t + 2) * kstep; const char* b2 = last ? nB : cB + (size_t)(t + 2) * kstep;
            const char* a3 = a2 + kstep; const char* b3 = b2 + kstep;
            const size_t ka2 = last ? 0 : (size_t)(t + 2) * kstep;
            if (last && has_next) S.a_ready(nxt);
            if constexpr (SP2) {
            PG8_LDB(B0, 0, 0); PG8_LDB(B1, 0, 1); PG8_SCHED; PG8_LDA(At, 0, 0); PG8_STA(1, 1, a1 + hstep, (size_t)(t + 1) * kstep, false);
            PG8_WAIT_V(8); PG8_WAIT_L(0); PG8_BAR; PG8_MMA(0, 0, At, B0); PG8_MMA(0, 1, At, B1); PG8_BAR; PG8_SCHED;
            PG8_LDA(At, 0, 1); PG8_STAGE(PG8_SB(0, 0), b2, voffB); PG8_STAGE(PG8_SB(0, 1), b2 + hstep, voffB); PG8_STA(0, 0, a2, ka2, last);
            PG8_WAIT_V(8); PG8_WAIT_L(0); PG8_BAR; PG8_MMA(1, 0, At, B0); PG8_MMA(1, 1, At, B1); PG8_BAR; PG8_SCHED;
            PG8_LDB(B0, 1, 0); PG8_LDB(B1, 1, 1); PG8_SCHED; PG8_LDA(At, 1, 0); PG8_STA(0, 1, a2 + hstep, ka2, last);
            PG8_WAIT_V(8); PG8_WAIT_L(0); PG8_BAR; PG8_MMA(0, 0, At, B0); PG8_MMA(0, 1, At, B1); PG8_BAR; PG8_SCHED;
            PG8_LDA(At, 1, 1); PG8_STAGE(PG8_SB(1, 0), b3, voffB); PG8_STAGE(PG8_SB(1, 1), b3 + hstep, voffB); PG8_STA(1, 0, a3, ka2 + kstep, last);
            PG8_WAIT_V(8); PG8_WAIT_L(0); PG8_BAR; PG8_MMA(1, 0, At, B0); PG8_MMA(1, 1, At, B1); PG8_BAR; PG8_SCHED;
            } else {
            PG8_LDB(B0, 0, 0); PG8_SCHED; PG8_LDA(At, 0, 0); PG8_STAGE(PG8_SA(1, 1), a1 + hstep, voffA);
            PG8_WAIT_L(8); PG8_BAR; PG8_WAIT_L(0); PG8_MMA(0, 0, At, B0); PG8_BAR; PG8_SCHED;
            PG8_LDB(B1, 0, 1); PG8_STAGE(PG8_SB(0, 0), b2, voffB);
            PG8_BAR; PG8_WAIT_L(0); PG8_MMA(0, 1, At, B1); PG8_BAR;
            PG8_LDA(At, 0, 1); PG8_STAGE(PG8_SA(0, 0), a2, voffA);
            PG8_BAR; PG8_WAIT_L(0); PG8_MMA(1, 0, At, B0); PG8_BAR; PG8_SCHED;
            PG8_STAGE(PG8_SB(0, 1), b2 + hstep, voffB);
            PG8_WAIT_V(6); PG8_BAR; PG8_MMA(1, 1, At, B1); PG8_BAR;
            PG8_LDB(B0, 1, 0); PG8_SCHED; PG8_LDA(At, 1, 0); PG8_STAGE(PG8_SA(0, 1), a2 + hstep, voffA);
            PG8_WAIT_L(8); PG8_BAR; PG8_WAIT_L(0); PG8_MMA(0, 0, At, B0); PG8_BAR; PG8_SCHED;
            PG8_LDB(B1, 1, 1); PG8_STAGE(PG8_SB(1, 0), b3, voffB);
            PG8_BAR; PG8_WAIT_L(0); PG8_MMA(0, 1, At, B1); PG8_BAR;
            PG8_LDA(At, 1, 1); PG8_STAGE(PG8_SA(1, 0), a3, voffA);
            PG8_BAR; PG8_WAIT_L(0); PG8_MMA(1, 0, At, B0); PG8_BAR; PG8_SCHED;
            PG8_STAGE(PG8_SB(1, 1), b3 + hstep, voffB);
            PG8_WAIT_V(6); PG8_BAR; PG8_MMA(1, 1, At, B1); PG8_BAR;
            }
        }
        if constexpr (ALIGN_EPI) { if (wr == 0) PG8_BAR; }
        if constexpr (FP8) asm volatile("s_nop 15\n\ts_nop 15" ::: "memory");
        if constexpr (Epi::HAS_INIT) { if (has_next) E.load_init(ini, nxt, wc, fq); }
        if constexpr (!Epi::AFTER_DRAIN) { E(acc, cur, wr, wc, fr, fq); S.done(cur); }
        if (!has_next) break;
#pragma unroll
        for (int a = 0; a < 2; ++a)
#pragma unroll
            for (int b = 0; b < 2; ++b)
#pragma unroll
                for (int m = 0; m < 4; ++m)
#pragma unroll
                    for (int n = 0; n < 2; ++n) { if constexpr (Epi::HAS_INIT) acc[a][b][m][n] = ini[b][n]; else acc[a][b][m][n] = (f32x4){0.f, 0.f, 0.f, 0.f}; }
        cur = nxt; cA = nA; cB = nB; ++ui;
        if constexpr (GATHER) { _Pragma("unroll") for (int h_ = 0; h_ < 2; ++h_) _Pragma("unroll") for (int i_ = 0; i_ < 2; ++i_) gA[h_][i_] = gN[h_][i_]; }
        if constexpr (ALIGN_EPI) { if (wr == 1) PG8_BAR; }
    }
    PG8_WAIT_V(0);
    if constexpr (!ALIGN_EPI) { if (wr == 0) PG8_BAR; }
    PG8_BAR;
    if constexpr (Epi::AFTER_DRAIN) { E.fused(acc, cur, wr, wc, fr, fq, lds, wid, lane); S.done(cur); }
#undef PG8_GLOAD
#undef PG8_STA
#undef PG8_SA
#undef PG8_SB
#undef PG8_STAGE
#undef PG8_LDA
#undef PG8_LDB
#undef PG8_MMA
#undef PG8_WAIT_V
#undef PG8_WAIT_L
#undef PG8_BAR
#undef PG8_SCHED
}
}

namespace att {
typedef short s16x4 __attribute__((ext_vector_type(4)));
typedef float f32x16 __attribute__((ext_vector_type(16)));
using pg8::bf16x8; using pg8::f32x4; using pg8::u32x4; using pg8::bf16_t;
constexpr int NW = 8, QBLK = 32, KVBLK = 64, QB = 256;
constexpr int SHM_V = 16384, SHM_KN = 16384, SHM_KR = 8192;
constexpr int OFF_V = 0, OFF_KN = 2 * SHM_V, OFF_KR = OFF_KN + 2 * SHM_KN, OFF_WS = OFF_KR + 2 * SHM_KR, LDS_BYTES = OFF_WS + NW * 64 * 4;
constexpr float SCALE = 0.07216878364870322f;
constexpr float THR = 8.f;
#define ATT_SBAR() __builtin_amdgcn_sched_barrier(0)
#define KSWZ(row, colB) ((row) * 256 + ((colB) ^ (((row) & 15) << 4)))
__device__ __forceinline__ int v_st(int k, int c) { const int kk = (k & ~0xC) | ((k & 4) << 1) | ((k & 8) >> 1); return ((kk >> 3) * 4 + (c >> 5)) * 512 + ((kk & 7) * 32 + (c & 31)) * 2; }
__device__ __forceinline__ int v_rd_base(int lane) { return ((lane & 3) << 3) | (((lane >> 2) & 3) << 6) | (((lane >> 4) & 1) << 5) | (((lane >> 5) & 1) << 8); }
constexpr int v_rd_off(int d0, int ks, int half) { return d0 * 512 + ks * 4096 + half * 2048; }
__device__ __forceinline__ int crow(int r, int hi) { return (r & 3) + 8 * (r >> 2) + 4 * hi; }
__device__ __forceinline__ unsigned cvtpk(float lo, float hi) { return pg8::cvt_pk_bf16(lo, hi); }

__device__ __forceinline__ void mask_tile(f32x16& p0, f32x16& p1, int dq) {
    const float NEG = -__builtin_inff();
#pragma unroll
    for (int r = 0; r < 16; ++r) {
        const int c = (r & 3) + 8 * (r >> 2);
        if (dq - c < 0) p0[r] = NEG;
        if (dq - c - 32 < 0) p1[r] = NEG;
    }
}
template <bool NOEXP = false, bool NOSM = false>
__device__ __forceinline__ void partialSM(f32x16& p0, f32x16& p1, float& m_reg, float& alpha) {
    if constexpr (NOSM) { alpha = 1.f; return; }
    float pmax = p0[0];
#pragma unroll
    for (int r = 1; r < 16; ++r) pmax = fmaxf(pmax, p0[r]);
#pragma unroll
    for (int r = 0; r < 16; ++r) pmax = fmaxf(pmax, p1[r]);
    { auto rr = __builtin_amdgcn_permlane32_swap(__float_as_uint(pmax), __float_as_uint(pmax), false, false);
      pmax = fmaxf(__uint_as_float(rr[0]), __uint_as_float(rr[1])); }
    constexpr float C2 = 1.4426950408889634f * SCALE;
    float mn;
    if (__builtin_expect(__all((pmax - m_reg) * SCALE <= THR), 1)) { mn = m_reg; alpha = 1.f; }
    else { mn = fmaxf(m_reg, pmax); alpha = __builtin_amdgcn_exp2f((m_reg - mn) * C2); m_reg = mn; }
    const float mnL = -mn * C2;
#pragma unroll
    for (int r = 0; r < 16; ++r) p0[r] = NOEXP ? fmaf(p0[r], C2, mnL) : __builtin_amdgcn_exp2f(fmaf(p0[r], C2, mnL));
#pragma unroll
    for (int r = 0; r < 16; ++r) p1[r] = NOEXP ? fmaf(p1[r], C2, mnL) : __builtin_amdgcn_exp2f(fmaf(p1[r], C2, mnL));
}
template <bool NOSUM = false>
__device__ __forceinline__ void finishSM(const f32x16& p0, const f32x16& p1, float alpha, float& l_reg, bf16x8& pa0, bf16x8& pa1, bf16x8& pa2, bf16x8& pa3) {
    float ps = 0;
    if constexpr (!NOSUM) {
#pragma unroll
    for (int r = 0; r < 16; ++r) ps += p0[r];
#pragma unroll
    for (int r = 0; r < 16; ++r) ps += p1[r];
    { auto rr = __builtin_amdgcn_permlane32_swap(__float_as_uint(ps), __float_as_uint(ps), false, false);
      ps = __uint_as_float(rr[0]) + __uint_as_float(rr[1]); }
    l_reg = l_reg * alpha + ps; }
#define ATT_PK4(P, B_, OUT) do { unsigned a0 = cvtpk(P[B_+0], P[B_+1]), a1 = cvtpk(P[B_+2], P[B_+3]);                          \
        unsigned b0 = cvtpk(P[B_+4], P[B_+5]), b1 = cvtpk(P[B_+6], P[B_+7]);                                             \
        auto r0 = __builtin_amdgcn_permlane32_swap(a0, b0, false, false); auto r1 = __builtin_amdgcn_permlane32_swap(a1, b1, false, false); \
        u32x4 w = {r0[0], r1[0], r0[1], r1[1]}; OUT = __builtin_bit_cast(bf16x8, w); } while (0)
    ATT_PK4(p0, 0, pa0); ATT_PK4(p0, 8, pa1); ATT_PK4(p1, 0, pa2); ATT_PK4(p1, 8, pa3);
#undef ATT_PK4
}
__device__ __forceinline__ void qkt(f32x16& p0, f32x16& p1, const LAS char* kn, const LAS char* kr, int r32, int hi, const bf16x8* qr) {
    p0 = f32x16{}; p1 = f32x16{};
    const int sw = ((r32 >> 1) & 7) << 4;
    const LAS char* kr0 = kr + r32 * 128;
    bf16x8 fa[3], fb[3];
#define ATT_KLD(i, slot) do { if ((i) < 8) { const LAS char* a_ = kn + KSWZ(r32, ((i) * 16 + hi * 8) * 2); fa[slot] = *(const LAS bf16x8*)a_; fb[slot] = *(const LAS bf16x8*)(a_ + 32 * 256); } \
        else { const LAS char* a_ = kr0 + (((2 * ((i) - 8) + hi) * 16) ^ sw); fa[slot] = *(const LAS bf16x8*)a_; fb[slot] = *(const LAS bf16x8*)(a_ + 32 * 128); } } while (0)
    ATT_KLD(0, 0); ATT_KLD(1, 1);
#pragma unroll
    for (int d0 = 0; d0 < 12; ++d0) {
        if (d0 + 2 < 12) ATT_KLD(d0 + 2, (d0 + 2) % 3);
        __builtin_amdgcn_sched_barrier(0);
        p0 = __builtin_amdgcn_mfma_f32_32x32x16_bf16(fa[d0 % 3], qr[d0], p0, 0, 0, 0);
        p1 = __builtin_amdgcn_mfma_f32_32x32x16_bf16(fb[d0 % 3], qr[d0], p1, 0, 0, 0);
        __builtin_amdgcn_sched_barrier(0);
    }
#undef ATT_KLD
}
struct VFrag { s16x4 l0, l1, l2, l3, h0, h1, h2, h3; };
#define ATT_TRRD(dst, off) asm volatile("ds_read_b64_tr_b16 %0, %1 offset:%2" : "=&v"(dst) : "v"(vb0), "i"(off) : "memory")
#define ATT_VLD(F, d0) do { constexpr int b_ = v_rd_off(d0, 0, 0); \
        ATT_TRRD(F.l0, b_); ATT_TRRD(F.h0, b_ + 2048); ATT_TRRD(F.l1, b_ + 4096); ATT_TRRD(F.h1, b_ + 6144); ATT_TRRD(F.l2, b_ + 8192); ATT_TRRD(F.h2, b_ + 10240); ATT_TRRD(F.l3, b_ + 12288); ATT_TRRD(F.h3, b_ + 14336); } while (0)
#define ATT_VMM(F, d0) do { \
        o[d0] = __builtin_amdgcn_mfma_f32_32x32x16_bf16(pa0, (bf16x8){F.l0[0], F.l0[1], F.l0[2], F.l0[3], F.h0[0], F.h0[1], F.h0[2], F.h0[3]}, o[d0], 0, 0, 0);   \
        o[d0] = __builtin_amdgcn_mfma_f32_32x32x16_bf16(pa1, (bf16x8){F.l1[0], F.l1[1], F.l1[2], F.l1[3], F.h1[0], F.h1[1], F.h1[2], F.h1[3]}, o[d0], 0, 0, 0);   \
        o[d0] = __builtin_amdgcn_mfma_f32_32x32x16_bf16(pa2, (bf16x8){F.l2[0], F.l2[1], F.l2[2], F.l2[3], F.h2[0], F.h2[1], F.h2[2], F.h2[3]}, o[d0], 0, 0, 0);   \
        o[d0] = __builtin_amdgcn_mfma_f32_32x32x16_bf16(pa3, (bf16x8){F.l3[0], F.l3[1], F.l3[2], F.l3[3], F.h3[0], F.h3[1], F.h3[2], F.h3[3]}, o[d0], 0, 0, 0); } while (0)
__device__ __forceinline__ void pv_pre(VFrag& fa, int vb0) { ATT_VLD(fa, 0); }
__device__ __forceinline__ void pv_tile(f32x16* o, int vb0, VFrag& fa, bf16x8 pa0, bf16x8 pa1, bf16x8 pa2, bf16x8 pa3) {
    VFrag fb;
    ATT_VLD(fb, 1); asm volatile("s_waitcnt lgkmcnt(8)" ::: "memory"); ATT_SBAR(); ATT_VMM(fa, 0); ATT_SBAR();
    ATT_VLD(fa, 2); asm volatile("s_waitcnt lgkmcnt(8)" ::: "memory"); ATT_SBAR(); ATT_VMM(fb, 1); ATT_SBAR();
    ATT_VLD(fb, 3); asm volatile("s_waitcnt lgkmcnt(8)" ::: "memory"); ATT_SBAR(); ATT_VMM(fa, 2); ATT_SBAR();
    asm volatile("s_waitcnt lgkmcnt(0)" ::: "memory"); ATT_SBAR(); ATT_VMM(fb, 3);
}
#undef ATT_VMM
#undef ATT_VLD
#undef ATT_TRRD

struct Tensors { const bf16_t* Q; const bf16_t* KN; const bf16_t* KR; const bf16_t* V; const bf16_t* GM; bf16_t* MIX; };

template <int VAR = 0, bool RMW = false>
__device__ __forceinline__ void attn_unit(const Tensors& X, int b, int h, int qb, LAS char* lds) {
    int tid_ = threadIdx.x; asm volatile("" : "+v"(tid_));
    const int tid = tid_, wid = __builtin_amdgcn_readfirstlane(tid >> 6), lane = tid & 63, r32 = lane & 31, hi = lane >> 5;
    const size_t tok0 = (size_t)b * 4096;
    const int q0 = qb * QB, qlo = q0 + wid * QBLK;
    const int NT = (q0 + QB) / KVBLK;
    bf16x8 qr[12];
    { const bf16_t* qp = X.Q + (tok0 + qlo + r32) * 1536 + h * 192 + hi * 8;
#pragma unroll
      for (int d0 = 0; d0 < 12; ++d0) qr[d0] = *(const bf16x8*)(qp + d0 * 16); }
    const char* Vu = (const char*)(X.V + tok0 * 1024 + h * 128); const char* Ku = (const char*)(X.KN + tok0 * 1024 + h * 128); const char* Ru = (const char*)(X.KR + tok0 * 64);
    unsigned koff[2], voff[2], roff;
#pragma unroll
    for (int j = 0; j < 2; ++j) {
        { const int r = 4 * (2 * wid + j) + (lane >> 4), p = lane & 15; koff[j] = (unsigned)(r * 2048 + ((p ^ (r & 15)) << 4)); }
        { const int blk = 2 * (2 * wid + j) + (lane >> 5), q = lane & 31, kk = (blk >> 2) * 8 + (q >> 2), c = (blk & 3) * 32 + (q & 3) * 8;
          const int k = (kk & ~0xC) | ((kk & 4) << 1) | ((kk & 8) >> 1); voff[j] = (unsigned)(k * 2048 + c * 2); } }
    { const int rr = 8 * wid + (lane >> 3), p = lane & 7; roff = (unsigned)(rr * 128 + ((p ^ ((rr >> 1) & 7)) << 4)); }
    float* wsf = (float*)(lds + OFF_WS) + wid * 64;
    LAS float* wsl = (LAS float*)(lds + OFF_WS) + wid * 64; (void)wsf;
    const int vbase = (int)(unsigned)(uintptr_t)(lds + OFF_V) + v_rd_base(lane);
#define ATT_DMA(t, bf) do { const size_t k0_ = (size_t)(t) * KVBLK; _Pragma("unroll") for (int j_ = 0; j_ < 2; ++j_) { \
            __builtin_amdgcn_global_load_lds((const unsigned*)(Ku + k0_ * 2048 + koff[j_]), (LAS unsigned*)(lds + OFF_KN + (bf) * SHM_KN + (2 * wid + j_) * 1024), 16, 0, 0); \
            __builtin_amdgcn_global_load_lds((const unsigned*)(Vu + k0_ * 2048 + voff[j_]), (LAS unsigned*)(lds + OFF_V + (bf) * SHM_V + (2 * wid + j_) * 1024), 16, 0, 0); } \
        __builtin_amdgcn_global_load_lds((const unsigned*)(Ru + k0_ * 128 + roff), (LAS unsigned*)(lds + OFF_KR + (bf) * SHM_KR + wid * 1024), 16, 0, 0); } while (0)
    float m_reg = -1e30f, l_reg = 0.f; f32x16 o[4] = {};
    asm volatile("" : "+v"(qr[0]), "+v"(qr[1]), "+v"(qr[2]), "+v"(qr[3]), "+v"(qr[4]), "+v"(qr[5]), "+v"(qr[6]), "+v"(qr[7]), "+v"(qr[8]), "+v"(qr[9]), "+v"(qr[10]), "+v"(qr[11]));
    ATT_DMA(0, 0);
    asm volatile("s_waitcnt vmcnt(0)" ::: "memory");
    __syncthreads();
#define ATT_ITER(t) do { const int bf = (t) & 1; \
        if constexpr (!(VAR & 32)) ATT_DMA((t) + 1 < NT ? (t) + 1 : NT - 1, bf ^ 1);        \
        const int kb = (t) * KVBLK; \
        if (kb <= qlo + QBLK - 1) { \
            f32x16 p0, p1; float alpha; bf16x8 pa0, pa1, pa2, pa3; VFrag vf; \
            if constexpr (VAR & 4) { _Pragma("unroll") for (int r = 0; r < 16; ++r) { p0[r] = __uint_as_float(qr[r % 12][0] << 16); p1[r] = __uint_as_float(qr[r % 12][1] << 16); } } else \
            qkt(p0, p1, lds + OFF_KN + bf * SHM_KN, lds + OFF_KR + bf * SHM_KR, r32, hi, qr); \
            if (kb + KVBLK - 1 > qlo) mask_tile(p0, p1, qlo + r32 - kb - 4 * hi); \
            partialSM<(VAR & 1) != 0, (VAR & 16) != 0>(p0, p1, m_reg, alpha); \
            if (__any(alpha < 1.f)) { \
                if (hi == 0) wsl[r32] = alpha; \
                asm volatile("s_waitcnt lgkmcnt(0)" ::: "memory"); \
                _Pragma("unroll") for (int d_ = 0; d_ < 4; ++d_) _Pragma("unroll") for (int r = 0; r < 16; ++r) o[d_][r] *= wsl[crow(r, hi)]; \
            } \
            finishSM<(VAR & 16) != 0>(p0, p1, alpha, l_reg, pa0, pa1, pa2, pa3); \
            pv_pre(vf, vbase + bf * SHM_V); \
            ATT_SBAR(); \
            if constexpr (VAR & 8) { asm volatile("s_waitcnt lgkmcnt(0)" ::: "memory"); o[0][0] += __uint_as_float((unsigned)pa0[0] << 16) + __uint_as_float((unsigned)vf.l0[0] << 16); } else \
            pv_tile(o, vbase + bf * SHM_V, vf, pa0, pa1, pa2, pa3); \
        } \
        if constexpr (VAR & 2) asm volatile("s_waitcnt vmcnt(0) lgkmcnt(0)" ::: "memory"); else asm volatile("s_waitcnt vmcnt(0) lgkmcnt(0)\n\ts_barrier" ::: "memory"); } while (0)
#pragma unroll 1
    for (int t = 0; t < NT; t += 2) {
        ATT_ITER(t);
        ATT_ITER(t + 1);
    }
#undef ATT_ITER
    if (hi == 0) wsl[32 + r32] = l_reg;
    asm volatile("s_waitcnt lgkmcnt(0)" ::: "memory");
    float rli[16];
#pragma unroll
    for (int r = 0; r < 16; ++r) rli[r] = __builtin_amdgcn_rcpf(wsl[32 + crow(r, hi)]);
#pragma unroll
    for (int rh = 0; rh < 16; rh += 8) {
        unsigned short gmv[8][4]; unsigned mw[8][4];
#pragma unroll
        for (int r = 0; r < 8; ++r) { const size_t trow = tok0 + qlo + crow(rh + r, hi);
#pragma unroll
            for (int d0 = 0; d0 < 4; ++d0) { gmv[r][d0] = X.GM[trow * 1024 + h * 128 + d0 * 32 + r32];
                if constexpr (RMW) mw[r][d0] = *(const unsigned*)(X.MIX + trow * 1024 + h * 128 + d0 * 32 + (r32 & ~1)); else mw[r][d0] = 0u; } }
#pragma unroll
        for (int r = 0; r < 8; ++r) { const size_t trow = tok0 + qlo + crow(rh + r, hi);
#pragma unroll
            for (int d0 = 0; d0 < 4; ++d0) { const size_t off = trow * 1024 + h * 128 + d0 * 32 + r32;
                const float g = __uint_as_float((unsigned)gmv[r][d0] << 16);
                float v = o[d0][rh + r] * rli[rh + r] * g;
                if constexpr (RMW) v += __uint_as_float((r32 & 1) ? (mw[r][d0] & 0xffff0000u) : (mw[r][d0] << 16));
                const float vn = __shfl_xor(v, 1);
                if ((r32 & 1) == 0) *(unsigned*)(X.MIX + off) = cvtpk(v, vn); } }
    }
    asm volatile("s_waitcnt vmcnt(0)" ::: "memory");
    __syncthreads();
#undef ATT_DMA
}
template <int VAR = 0>
__device__ __forceinline__ void attn_phase(const Tensors& X, LAS char* lds, int vcu, int G) {
    for (int it = vcu; it < 256; it += G) {
        const int bh = it >> 3, x = it & 7;
        attn_unit<VAR>(X, bh >> 3, bh & 7, 15 - x, lds);
        attn_unit<VAR>(X, bh >> 3, bh & 7, x, lds);
    }
}
#undef KSWZ
#undef ATT_SBAR
}

#ifndef RET_PIPE
#define RET_PIPE 1
#endif
#ifndef RET_WIDE
#define RET_WIDE 1
#endif
#ifndef RET_REP
#define RET_REP 1
#endif
namespace ret {
using pg8::bf16x8; using pg8::f32x4; using pg8::u32x4; using pg8::bf16_t; using pg8::u32x2;
typedef short v4i16 __attribute__((ext_vector_type(4)));
constexpr int RS = 288;
constexpr int TILE = 128 * RS;
__device__ __forceinline__ float bf2f(short s) { return __uint_as_float(((unsigned)(unsigned short)s) << 16); }
__device__ __forceinline__ float lg2_gamma(int h) { const float x = exp2f(-5.0f - (float)h);
    return -x * (1.0f + x * (0.5f + x * (0.33333334f + x * (0.25f + x * (0.2f + x * 0.16666667f))))) * 1.4426950408889634f; }
struct Tile { bf16x8 v[4]; };
template <bool NT = false> __device__ __forceinline__ void tile_load(Tile& t, const bf16_t* src, size_t pitch, int tid) {
#pragma unroll
    for (int c = 0; c < 4; ++c) { const int idx = tid + 512 * c; const bf16x8* p = (const bf16x8*)(src + (size_t)(idx >> 4) * pitch + (idx & 15) * 8); t.v[c] = NT ? __builtin_nontemporal_load(p) : *p; }
}
template <bool SCALE> __device__ __forceinline__ void tile_store(const Tile& t, LAS char* slot, float lg2, int tid) {
#pragma unroll
    for (int c = 0; c < 4; ++c) { const int idx = tid + 512 * c, row = idx >> 4; bf16x8 v = t.v[c];
        if (SCALE) { const float w = exp2f((float)(127 - row) * lg2); u32x4 o;
            o.x = pg8::cvt_pk_bf16(bf2f(v[0]) * w, bf2f(v[1]) * w); o.y = pg8::cvt_pk_bf16(bf2f(v[2]) * w, bf2f(v[3]) * w); o.z = pg8::cvt_pk_bf16(bf2f(v[4]) * w, bf2f(v[5]) * w); o.w = pg8::cvt_pk_bf16(bf2f(v[6]) * w, bf2f(v[7]) * w);
            v = __builtin_bit_cast(bf16x8, o); }
        *(LAS bf16x8*)(slot + row * RS + (idx & 15) * 16) = v; }
}
__device__ __forceinline__ bf16x8 tr_frag(const LAS char* tile, int trb, int j0, int c0) {
    const LAS char* p = tile + trb + j0 * RS + c0 * 2;
    const v4i16 lo = __builtin_amdgcn_ds_read_tr16_b64_v4i16((LAS v4i16*)p), hi = __builtin_amdgcn_ds_read_tr16_b64_v4i16((LAS v4i16*)(p + 16 * RS));
    return (bf16x8){lo[0], lo[1], lo[2], lo[3], hi[0], hi[1], hi[2], hi[3]};
}
__device__ __forceinline__ void u_phase(const bf16_t* RK, const bf16_t* RV, bf16_t* UT, int vcu, int G, LAS char* lds) {
    int tid_ = threadIdx.x; asm volatile("" : "+v"(tid_));
    const int tid = tid_, wid = __builtin_amdgcn_readfirstlane(tid >> 6), lane = tid & 63, fr = lane & 15, fq = lane >> 4;
    const int trb = (((lane & 15) >> 2) + 4 * fq) * RS + (lane & 3) * 8;
    LAS char* Ks = lds; LAS char* Vs = lds + TILE;
    Tile tk, tv; int u = vcu;
    if (u < 1024) { const int bh = u >> 5, n = u & 31; const size_t off = ((size_t)(bh >> 3) * 4096 + (size_t)n * 128) * 1024 + (bh & 7) * 128; tile_load<true>(tk, RK + off, 1024, tid); tile_load<true>(tv, RV + off, 1024, tid); }
    for (; u < 1024; u += G) {
        const int bh = u >> 5, n = u & 31, h = bh & 7;
        tile_store<true>(tk, Ks, lg2_gamma(h), tid); tile_store<false>(tv, Vs, 0.f, tid);
        __syncthreads();
        if (u + G < 1024) { const int u2 = u + G, bh2 = u2 >> 5, n2 = u2 & 31; const size_t off = ((size_t)(bh2 >> 3) * 4096 + (size_t)n2 * 128) * 1024 + (bh2 & 7) * 128; tile_load<true>(tk, RK + off, 1024, tid); tile_load<true>(tv, RV + off, 1024, tid); }
        bf16x8 yf[4];
#pragma unroll
        for (int ks = 0; ks < 4; ++ks) yf[ks] = tr_frag(Vs, trb, 32 * ks, 16 * wid);
        LAS float* stg = (LAS float*)(lds + 2 * TILE) + wid * (16 * 132);
#pragma unroll
        for (int db = 0; db < 8; ++db) { f32x4 acc = {0.f, 0.f, 0.f, 0.f};
#pragma unroll
            for (int ks = 0; ks < 4; ++ks) acc = __builtin_amdgcn_mfma_f32_16x16x32_bf16(tr_frag(Ks, trb, 32 * ks, 16 * db), yf[ks], acc, 0, 0, 0);
            *(LAS f32x4*)(stg + fr * 132 + 16 * db + 4 * fq) = acc; }
        asm volatile("s_waitcnt lgkmcnt(0)" ::: "memory");
        { bf16_t* out = UT + ((size_t)(bh * 32 + n) * 128 + 16 * wid) * 128;
#pragma unroll
          for (int i = 0; i < 4; ++i) { const int row = 4 * i + (lane >> 4), c8 = (lane & 15) * 8; const f32x4 a = *(const LAS f32x4*)(stg + row * 132 + c8), b = *(const LAS f32x4*)(stg + row * 132 + c8 + 4);
              *(u32x4*)(out + (size_t)row * 128 + c8) = pg8::pack8(a, b); } }
        __syncthreads();
    }
}
__device__ __forceinline__ void scan_all(const bf16_t* UT, bf16_t* RT, int gtid, int gthreads) {
    for (int g = gtid; g < 32 * 4096; g += gthreads) { const int bh = g >> 12, q4 = g & 4095, h = bh & 7;
        const float cd = exp2f(128.0f * lg2_gamma(h));
        const bf16_t* up = UT + (size_t)bh * 32 * 16384 + (size_t)q4 * 4; bf16_t* rp = RT + (size_t)bh * 32 * 16384 + (size_t)q4 * 4;
        u32x2 uw[32];
#pragma unroll
        for (int n = 0; n < 32; ++n) uw[n] = __builtin_nontemporal_load((const u32x2*)(up + (size_t)n * 16384));
        f32x4 R = {0.f, 0.f, 0.f, 0.f};
#pragma unroll
        for (int n = 0; n < 32; ++n) { const f32x4 u = {__uint_as_float(uw[n].x << 16), __uint_as_float(uw[n].x & 0xffff0000u), __uint_as_float(uw[n].y << 16), __uint_as_float(uw[n].y & 0xffff0000u)};
            u32x2 w; w.x = pg8::cvt_pk_bf16(R[0], R[1]); w.y = pg8::cvt_pk_bf16(R[2], R[3]);
            *(u32x2*)(rp + (size_t)n * 16384) = w;
            R = R * cd + u; } }
}
__device__ __forceinline__ void out_phase(const bf16_t* RQ, const bf16_t* RK, const bf16_t* RV, const bf16_t* RT, const bf16_t* GR, const bf16_t* MIX, bf16_t* MIXO, int bhu, unsigned nlist, int NU, unsigned addmask, LAS char* lds) {
    int tid_ = threadIdx.x; asm volatile("" : "+v"(tid_));
    const int tid = tid_, wid = __builtin_amdgcn_readfirstlane(tid >> 6), lane = tid & 63, fr = lane & 15, fq = lane >> 4;
    const int trb = (((lane & 15) >> 2) + 4 * fq) * RS + (lane & 3) * 8;
    const int il0 = 16 * wid + fr;
    LAS char* Rs = lds; LAS char* Ks = lds + TILE; LAS char* Vs = lds + 2 * TILE;
    Tile tr, tk, tv; bf16x8 qn[4];
#define RET_UNIT(i_) (bhu * 32 + (int)((nlist >> (8 * (i_))) & 255u))
#define RET_LOAD(uu) do { const int bh_ = (uu) >> 5, n_ = (uu) & 31; const size_t off_ = ((size_t)(bh_ >> 3) * 4096 + (size_t)n_ * 128) * 1024 + (bh_ & 7) * 128; \
        tile_load<true>(tr, RT + (size_t)(bh_ * 32 + n_) * 16384, 128, tid); tile_load<true>(tk, RK + off_, 1024, tid); tile_load<true>(tv, RV + off_, 1024, tid); \
        _Pragma("unroll") for (int ks = 0; ks < 4; ++ks) qn[ks] = __builtin_nontemporal_load((const bf16x8*)(RQ + off_ + (size_t)il0 * 1024 + 32 * ks + 8 * fq)); } while (0)
    RET_LOAD(RET_UNIT(0));
    for (int ui = 0; ui < NU; ++ui) { const int u = RET_UNIT(ui); const bool addu = (addmask >> ui) & 1u;
        const bf16_t* msrc = addu ? MIX : GR;
        const int bh = u >> 5, n = u & 31, h = bh & 7; const float lg2 = lg2_gamma(h);
        int il = il0; asm volatile("" : "+v"(il));
        const size_t trow = (size_t)(bh >> 3) * 4096 + (size_t)n * 128 + il;
        tile_store<false>(tr, Rs, 0.f, tid); tile_store<false>(tk, Ks, 0.f, tid); tile_store<false>(tv, Vs, 0.f, tid);
        bf16x8 yq[4];
#pragma unroll
        for (int ks = 0; ks < 4; ++ks) yq[ks] = qn[ks];
        __syncthreads();
#if RET_WIDE
        u32x4 gv[4], mv[4];
        const int sw = fq & 1, pw = fq >> 1;
#pragma unroll
        for (int k = 0; k < 4; ++k) { const size_t off = trow * 1024 + h * 128 + 16 * (2 * k + sw) + 8 * pw; gv[k] = __builtin_nontemporal_load((const u32x4*)(GR + off)); mv[k] = __builtin_nontemporal_load((const u32x4*)(msrc + off)); }
#else
        u32x2 gv[8], mv[8];
#pragma unroll
        for (int eb = 0; eb < 8; ++eb) { const size_t off = trow * 1024 + h * 128 + 16 * eb + 4 * fq; gv[eb] = __builtin_nontemporal_load((const u32x2*)(GR + off)); mv[eb] = __builtin_nontemporal_load((const u32x2*)(msrc + off)); }
#endif
        { const int un = RET_UNIT(ui + 1 < NU ? ui + 1 : ui); RET_LOAD(un); }
        f32x4 acc[8];
        u32x2 sb[8];
#if RET_REP > 1
#pragma nounroll
        for (int rep_ = 0; rep_ < RET_REP; ++rep_) { asm volatile("" ::: "memory");
#endif
#if RET_PIPE
        bf16x8 fA[4], fB[4];
#define RD_ROW(F, base, blk) _Pragma("unroll") for (int ks = 0; ks < 4; ++ks) F[ks] = *(const LAS bf16x8*)((base) + (16 * (blk) + fr) * RS + (32 * ks + 8 * fq) * 2)
#define RD_TR(F, st, hf) _Pragma("unroll") for (int e = 0; e < 4; ++e) F[e] = tr_frag(Vs, trb, 32 * (st), 16 * (4 * (hf) + e))
#define MM4(F, a) _Pragma("unroll") for (int ks = 0; ks < 4; ++ks) a = __builtin_amdgcn_mfma_f32_16x16x32_bf16(F[ks], yq[ks], a, 0, 0, 0)
#define SBAR() __builtin_amdgcn_sched_barrier(0)
        RD_ROW(fA, Rs, 0);
#pragma unroll
        for (int e2 = 0; e2 < 4; ++e2) {
            RD_ROW(fB, Rs, 2 * e2 + 1); SBAR();
            acc[2 * e2] = (f32x4){0.f, 0.f, 0.f, 0.f}; MM4(fA, acc[2 * e2]); SBAR();
            if (e2 < 3) { RD_ROW(fA, Rs, 2 * e2 + 2); } else { RD_ROW(fA, Ks, 0); }
            SBAR();
            acc[2 * e2 + 1] = (f32x4){0.f, 0.f, 0.f, 0.f}; MM4(fB, acc[2 * e2 + 1]); SBAR();
        }
        { const float qw = exp2f((float)(il + 1) * lg2);
#pragma unroll
          for (int eb = 0; eb < 8; ++eb) acc[eb] = acc[eb] * qw; }
#define SC_FIN(jb, s) do { _Pragma("unroll") for (int r = 0; r < 4; ++r) { const int dl = il - (16 * (jb) + 4 * fq + r); s[r] = dl >= 0 ? s[r] * exp2f((float)dl * lg2) : 0.f; } \
            sb[jb].x = pg8::cvt_pk_bf16(s[0], s[1]); sb[jb].y = pg8::cvt_pk_bf16(s[2], s[3]); } while (0)
#pragma unroll
        for (int j2 = 0; j2 < 4; ++j2) { sb[2 * j2] = (u32x2){0u, 0u}; sb[2 * j2 + 1] = (u32x2){0u, 0u};
            if (2 * j2 <= wid) {
                if (2 * j2 + 1 <= wid) { RD_ROW(fB, Ks, 2 * j2 + 1); }
                SBAR();
                f32x4 s = {0.f, 0.f, 0.f, 0.f}; MM4(fA, s); SC_FIN(2 * j2, s); SBAR();
                if (2 * j2 + 1 <= wid) {
                    if (j2 < 3 && 2 * j2 + 2 <= wid) { RD_ROW(fA, Ks, 2 * j2 + 2); }
                    SBAR();
                    f32x4 s1 = {0.f, 0.f, 0.f, 0.f}; MM4(fB, s1); SC_FIN(2 * j2 + 1, s1); SBAR();
                } } }
        RD_TR(fA, 0, 0);
#pragma unroll
        for (int st = 0; st < 4; ++st) {
            if (2 * st <= wid) { const u32x4 yw = {sb[2 * st].x, sb[2 * st].y, sb[2 * st + 1].x, sb[2 * st + 1].y}; const bf16x8 ys = __builtin_bit_cast(bf16x8, yw);
                RD_TR(fB, st, 1); SBAR();
#pragma unroll
                for (int e = 0; e < 4; ++e) acc[e] = __builtin_amdgcn_mfma_f32_16x16x32_bf16(fA[e], ys, acc[e], 0, 0, 0);
                SBAR();
                if (st < 3 && 2 * st + 2 <= wid) { RD_TR(fA, st + 1, 0); }
                SBAR();
#pragma unroll
                for (int e = 0; e < 4; ++e) acc[4 + e] = __builtin_amdgcn_mfma_f32_16x16x32_bf16(fB[e], ys, acc[4 + e], 0, 0, 0);
                SBAR(); } }
#undef RD_ROW
#undef RD_TR
#undef MM4
#undef SBAR
#undef SC_FIN
#else
#pragma unroll
        for (int eb = 0; eb < 8; ++eb) { acc[eb] = (f32x4){0.f, 0.f, 0.f, 0.f};
#pragma unroll
            for (int ks = 0; ks < 4; ++ks) acc[eb] = __builtin_amdgcn_mfma_f32_16x16x32_bf16(*(const LAS bf16x8*)(Rs + (16 * eb + fr) * RS + (32 * ks + 8 * fq) * 2), yq[ks], acc[eb], 0, 0, 0); }
        { const float qw = exp2f((float)(il + 1) * lg2);
#pragma unroll
          for (int eb = 0; eb < 8; ++eb) acc[eb] = acc[eb] * qw; }
#pragma unroll
        for (int jb = 0; jb < 8; ++jb) { sb[jb] = (u32x2){0u, 0u};
            if (jb <= wid) { f32x4 s = {0.f, 0.f, 0.f, 0.f};
#pragma unroll
                for (int ks = 0; ks < 4; ++ks) s = __builtin_amdgcn_mfma_f32_16x16x32_bf16(*(const LAS bf16x8*)(Ks + (16 * jb + fr) * RS + (32 * ks + 8 * fq) * 2), yq[ks], s, 0, 0, 0);
#pragma unroll
                for (int r = 0; r < 4; ++r) { const int dl = il - (16 * jb + 4 * fq + r); s[r] = dl >= 0 ? s[r] * exp2f((float)dl * lg2) : 0.f; }
                sb[jb].x = pg8::cvt_pk_bf16(s[0], s[1]); sb[jb].y = pg8::cvt_pk_bf16(s[2], s[3]); } }
#pragma unroll
        for (int st = 0; st < 4; ++st) {
            if (2 * st <= wid) { const u32x4 yw = {sb[2 * st].x, sb[2 * st].y, sb[2 * st + 1].x, sb[2 * st + 1].y}; const bf16x8 ys = __builtin_bit_cast(bf16x8, yw);
#pragma unroll
                for (int eb = 0; eb < 8; ++eb) acc[eb] = __builtin_amdgcn_mfma_f32_16x16x32_bf16(tr_frag(Vs, trb, 32 * st, 16 * eb), ys, acc[eb], 0, 0, 0); } }
#endif
#if RET_REP > 1
        }
#endif
        float s1 = 0.f;
#pragma unroll
        for (int eb = 0; eb < 8; ++eb) s1 += (acc[eb][0] + acc[eb][1]) + (acc[eb][2] + acc[eb][3]);
        s1 = pg8::swap_sum32(pg8::swap_sum16(s1));
        const float mu = s1 * (1.0f / 128.0f); float s2 = 0.f;
#pragma unroll
        for (int eb = 0; eb < 8; ++eb) { const f32x4 d = acc[eb] - mu; s2 += (d[0] * d[0] + d[1] * d[1]) + (d[2] * d[2] + d[3] * d[3]); }
        s2 = pg8::swap_sum32(pg8::swap_sum16(s2));
        const float rstd = __builtin_amdgcn_rsqf(s2 * (1.0f / 128.0f) + 1e-6f);
#if RET_WIDE
#pragma unroll
        for (int k = 0; k < 4; ++k) { const size_t off = trow * 1024 + h * 128 + 16 * (2 * k + sw) + 8 * pw;
            const f32x4 a0 = (acc[2 * k] - mu) * rstd, a1 = (acc[2 * k + 1] - mu) * rstd;
            const unsigned ax = pg8::cvt_pk_bf16(a0[0], a0[1]), ay = pg8::cvt_pk_bf16(a0[2], a0[3]), bx = pg8::cvt_pk_bf16(a1[0], a1[1]), by = pg8::cvt_pk_bf16(a1[2], a1[3]);
            const auto sx = __builtin_amdgcn_permlane16_swap(ax, bx, false, false); const auto sy = __builtin_amdgcn_permlane16_swap(ay, by, false, false);
            const unsigned o[4] = {sx[0], sy[0], sx[1], sy[1]};
            const u32x4 g = gv[k]; u32x4 mx = mv[k]; if (!addu) mx = (u32x4){0u, 0u, 0u, 0u}; u32x4 w;
#pragma unroll
            for (int q = 0; q < 4; ++q) { const float r0 = __uint_as_float(mx[q] << 16) + __uint_as_float(g[q] << 16) * __uint_as_float(o[q] << 16), r1 = __uint_as_float(mx[q] & 0xffff0000u) + __uint_as_float(g[q] & 0xffff0000u) * __uint_as_float(o[q] & 0xffff0000u);
                w[q] = pg8::cvt_pk_bf16(r0, r1); }
            *(u32x4*)(MIXO + off) = w; }
#else
#pragma unroll
        for (int eb = 0; eb < 8; ++eb) { const size_t off = trow * 1024 + h * 128 + 16 * eb + 4 * fq;
            const u32x2 g = gv[eb]; u32x2 mx = mv[eb]; if (!addu) mx = (u32x2){0u, 0u};
            const float o0 = (acc[eb][0] - mu) * rstd, o1 = (acc[eb][1] - mu) * rstd, o2 = (acc[eb][2] - mu) * rstd, o3 = (acc[eb][3] - mu) * rstd;
            const float r0 = __uint_as_float(mx.x << 16) + __uint_as_float(g.x << 16) * o0, r1 = __uint_as_float(mx.x & 0xffff0000u) + __uint_as_float(g.x & 0xffff0000u) * o1;
            const float r2 = __uint_as_float(mx.y << 16) + __uint_as_float(g.y << 16) * o2, r3 = __uint_as_float(mx.y & 0xffff0000u) + __uint_as_float(g.y & 0xffff0000u) * o3;
            u32x2 w; w.x = pg8::cvt_pk_bf16(r0, r1); w.y = pg8::cvt_pk_bf16(r2, r3);
            *(u32x2*)(MIXO + off) = w; }
#endif
        asm volatile("s_waitcnt vmcnt(0)" ::: "memory");
        __syncthreads();
    }
#undef RET_LOAD
#undef RET_UNIT
}
}

constexpr int NWAVES = 8;
#ifndef MK_PER_PHASE
#define MK_PER_PHASE 0
#endif
constexpr int NPH = 11;
constexpr int NB = 4, SEQ = 4096, T = NB * SEQ, DM = 1024;
constexpr int NP1 = 6912;
constexpr int NE = 32, PMAX = T * 4 + NE * 256, MT_MAX = PMAX / 256;
constexpr float LN_EPS = 1e-5f, DN_ALPHA = 1.189207115002721f;

constexpr size_t MiB = 1u << 20;
constexpr size_t WS_CTL = 0, CTL_ZERO_BYTES = 1 * MiB;
constexpr size_t WS_WIN = 1 * MiB, WS_WUQ = 15 * MiB, WS_WUKV = 17 * MiB, WS_WO = 18 * MiB, WS_WUP = 20 * MiB, WS_WDN = 148 * MiB;
constexpr size_t WS_XB = 212 * MiB, WS_COSM = 244 * MiB, WS_SINM = 246 * MiB, WS_COSR = 248 * MiB, WS_SINR = 252 * MiB;
constexpr size_t WS_Y = 256 * MiB, WS_H1 = 320 * MiB, WS_H1B = 384 * MiB;
constexpr size_t WS_TOPI = 416 * MiB, WS_GATE = WS_TOPI + 512 * 1024, WS_RANK = WS_GATE + 512 * 1024, WS_SLOT = WS_RANK + 512 * 1024, WS_TILEE = WS_SLOT + 512 * 1024, WS_ROWTOK = WS_TILEE + 64 * 1024, WS_SSQQ = 419 * MiB, WS_SSQKV = WS_SSQQ + 512 * 1024;
constexpr size_t WS_OV = 420 * MiB;
constexpr size_t WS_CQ = WS_OV, WS_CKV = WS_OV + 12 * MiB, WS_KR = WS_OV + 20 * MiB, WS_RQ = WS_OV + 22 * MiB, WS_RK = WS_OV + 54 * MiB, WS_RV = WS_OV + 86 * MiB,
                 WS_GR = WS_OV + 118 * MiB, WS_GM = WS_OV + 150 * MiB, WS_QB = WS_OV + 182 * MiB, WS_KN = WS_OV + 230 * MiB, WS_VB = WS_OV + 262 * MiB,
                 WS_UT = WS_OV + 294 * MiB, WS_RT = WS_OV + 358 * MiB, WS_MIX = WS_OV + 390 * MiB;
constexpr size_t WS_H1Q = WS_OV  , WS_XS = WS_OV, WS_A2 = WS_OV + 144 * MiB, WS_YS = WS_OV + 288 * MiB, WS_END = WS_OV + 432 * MiB;
static_assert((size_t)PMAX * 1024 * 2 == 144 * MiB && WS_MIX + 32 * MiB <= WS_END && WS_END <= 1024 * MiB, "d_ws map");

constexpr int CW_TMO = 0, CW_CODE = 1, CW_BAR = 4096, CW_CNT = 8192, CW_NMT = 8256, CW_SSQQ = 16384, CW_SSQKV = 32768;
constexpr int CW_C3 = 8512;
constexpr int CW_XMAP = 8320, CW_C5 = 8448;
constexpr int WS_ROWE_STRIDE = 16384;

constexpr int RING_OFF = 0, RING_BYTES = 131072;
constexpr int RT_W_BYTES = 1024 * 36 * 4;
constexpr int RT_LIST_OFF = RT_W_BYTES;
constexpr int RT_SCR_OFF = RT_LIST_OFF + 1024;
constexpr int MISC_OFF = 151552, LDS_BYTES = 152576;
static_assert(RT_SCR_OFF + 8 * 384 <= MISC_OFF && MISC_OFF + 128 <= LDS_BYTES, "LDS map");

#define GAS __attribute__((address_space(1)))
typedef unsigned short bf16;
typedef unsigned v4u __attribute__((ext_vector_type(4)));
typedef unsigned v2u __attribute__((ext_vector_type(2)));
typedef int i32x4 __attribute__((ext_vector_type(4)));
typedef float f32x4 __attribute__((ext_vector_type(4)));
typedef GAS unsigned gu32;
#define RLX_AGENT __ATOMIC_RELAXED, __HIP_MEMORY_SCOPE_AGENT
#define LDS_WAIT() asm volatile("s_waitcnt lgkmcnt(0)" ::: "memory")
#define VM_WAIT() asm volatile("s_waitcnt vmcnt(0)" ::: "memory")
__device__ __forceinline__ unsigned f2bf(float f) { unsigned u = __builtin_bit_cast(unsigned, f); return (u + 0x7fffu + ((u >> 16) & 1u)) >> 16; }
__device__ __forceinline__ unsigned pk2(float lo, float hi) { return f2bf(lo) | (f2bf(hi) << 16); }

#define XB_TMO      128
#define XB_XCNT(j)  (256  + 64 * (j))
#define XB_XSUB(j)  (1280 + 64 * (j))
#define XB_XGEN(j)  (2304 + 64 * (j))
#define XB_TOP      3328
#define XB_TOPGEN   3392
#define XCD_BAR_WORDS 3456
#define XB_SPIN_CAP (1u << 18)

__device__ __forceinline__ unsigned xb_ld(unsigned* p)              { return __hip_atomic_load(p, __ATOMIC_RELAXED, __HIP_MEMORY_SCOPE_AGENT); }
__device__ __forceinline__ unsigned xb_add(unsigned* p, unsigned v) { return __hip_atomic_fetch_add(p, v, __ATOMIC_RELAXED, __HIP_MEMORY_SCOPE_AGENT); }
__device__ __forceinline__ unsigned xb_xcc_id() { return (unsigned)__builtin_amdgcn_s_getreg((3 << 11) | 20) & 0xFu; }
#define XB_SPIN(cond, bar) do { unsigned _sp = 0; while (cond) { __builtin_amdgcn_s_sleep(1); \
    if ((++_sp & 255u) == 0u) { if (xb_ld(&(bar)[XB_TMO])) break; if (_sp > XB_SPIN_CAP) { atomicAdd(&(bar)[XB_TMO], 1u); break; } } } } while (0)

struct XcdBarrier {
    unsigned* bar; unsigned x;
    volatile LAS unsigned* st;
};

__device__ __forceinline__ XcdBarrier xcd_barrier_post(unsigned* bar, volatile LAS unsigned* st) {
    XcdBarrier b; b.bar = bar; b.x = xb_xcc_id(); b.st = st;
    if (threadIdx.x == 0) (void)xb_add(&bar[XB_XCNT(b.x)], 1u);
    return b;
}
__device__ __forceinline__ void xcd_barrier_complete(unsigned* bar, unsigned x, unsigned& nloc, unsigned& nx) {
    const unsigned G = gridDim.x * gridDim.y * gridDim.z;
    unsigned sum, cnt, mine, sp = 0u;
    for (;;) {
        sum = 0u; cnt = 0u; mine = 0u;
#pragma unroll
        for (unsigned j = 0; j < 16; ++j) { const unsigned c = xb_ld(&bar[XB_XCNT(j)]); sum += c; cnt += (c > 0u) ? 1u : 0u; mine = (j == x) ? c : mine; }
        if (sum == G) break;
        __builtin_amdgcn_s_sleep(1);
        if ((++sp & 255u) == 0u) { if (xb_ld(&bar[XB_TMO])) break; if (sp > XB_SPIN_CAP) { atomicAdd(&bar[XB_TMO], 1u); break; } }
    }
    nloc = mine > 0u ? mine : 1u; nx = cnt > 0u ? cnt : 1u;
}

__device__ __forceinline__ void xcd_barrier(const XcdBarrier& b) {
    asm volatile("s_waitcnt vmcnt(0)" ::: "memory");
    __syncthreads();
    if (threadIdx.x == 0) {
        unsigned* bar = b.bar;
        __builtin_amdgcn_s_waitcnt(0);
        unsigned nloc = b.st[0], nx = b.st[1];
        if (nloc == 0u) { xcd_barrier_complete(bar, b.x, nloc, nx); b.st[0] = nloc; b.st[1] = nx; }
        const unsigned old = xb_add(&bar[XB_XSUB(b.x)], 1u);
        const unsigned gen = old / nloc;
        if (old + 1u == (gen + 1u) * nloc) {
            __builtin_amdgcn_fence(__ATOMIC_RELEASE, "agent");
            asm volatile("s_waitcnt vmcnt(0)" ::: "memory");
            const unsigned og = xb_add(&bar[XB_TOP], 1u);
            const unsigned tg = og / nx;
            if (og + 1u == (tg + 1u) * nx) xb_add(&bar[XB_TOPGEN], 1u);
            else XB_SPIN(xb_ld(&bar[XB_TOPGEN]) == tg, bar);
            __builtin_amdgcn_fence(__ATOMIC_ACQUIRE, "agent");
            xb_add(&bar[XB_XGEN(b.x)], 1u);
            asm volatile("s_waitcnt vmcnt(0)" ::: "memory");
        } else {
            XB_SPIN(xb_ld(&bar[XB_XGEN(b.x)]) == gen, bar);
            __builtin_amdgcn_fence(__ATOMIC_ACQUIRE, "agent");
            asm volatile("s_waitcnt vmcnt(0)" ::: "memory");
        }
    }
    __syncthreads();
}


struct Frame {
    LAS unsigned char* lds;
    volatile LAS unsigned* MISC;
    unsigned* ctl;
    int tid, lane, wave, vcu, G;
};
__device__ __forceinline__ float wave_sum(float v) {
    return pg8::wave_allsum(v);
}
struct P0Item { const float* W; const float* kscale; bf16* WT; int ldw, K, src_col0, dst_row0, k0; bool valid, fp8; };
__device__ __forceinline__ void p0_load(const P0Item& d, f32x4 (&v)[8], int lane) {
    const int l8 = lane & 7, r8 = lane >> 3;
#pragma unroll
    for (int i = 0; i < 8; ++i) v[i] = __builtin_nontemporal_load((const f32x4*)(d.W + (size_t)(d.k0 + 8 * i + r8) * d.ldw + d.src_col0 + 4 * l8));
}
__device__ __forceinline__ void p0_finish(const P0Item& d, f32x4 (&v)[8], LAS float* scr, int lane) {
    if (!d.valid) return;
    const int l8 = lane & 7, r8 = lane >> 3;
    if (d.kscale) {
#pragma unroll
        for (int i = 0; i < 8; ++i) v[i] = v[i] * d.kscale[d.k0 + 8 * i + r8]; }
#pragma unroll
    for (int i = 0; i < 8; ++i) { LAS float* p = scr + (8 * i + r8) * 33 + 4 * l8; p[0] = v[i][0]; p[1] = v[i][1]; p[2] = v[i][2]; p[3] = v[i][3]; }
    LDS_WAIT(); asm volatile("" ::: "memory");
    if (d.fp8) {
        const int c = lane & 3;
#pragma unroll
        for (int j = 0; j < 2; ++j) { const int n = (lane >> 2) + 16 * j; const LAS float* s = scr + (16 * c) * 33 + n; v4u o;
            o.x = pg8::pack4_fp8(32.f * s[0 * 33], 32.f * s[1 * 33], 32.f * s[2 * 33], 32.f * s[3 * 33]); o.y = pg8::pack4_fp8(32.f * s[4 * 33], 32.f * s[5 * 33], 32.f * s[6 * 33], 32.f * s[7 * 33]);
            o.z = pg8::pack4_fp8(32.f * s[8 * 33], 32.f * s[9 * 33], 32.f * s[10 * 33], 32.f * s[11 * 33]); o.w = pg8::pack4_fp8(32.f * s[12 * 33], 32.f * s[13 * 33], 32.f * s[14 * 33], 32.f * s[15 * 33]);
            __builtin_nontemporal_store(o, (v4u*)((unsigned char*)d.WT + (size_t)(d.dst_row0 + n) * d.K + d.k0 + 16 * c)); }
    } else {
    const int c = lane & 7;
#pragma unroll
    for (int j = 0; j < 4; ++j) { const int n = (lane >> 3) + 8 * j; const LAS float* s = scr + (8 * c) * 33 + n;
        v4u o; o.x = pk2(s[0 * 33], s[1 * 33]); o.y = pk2(s[2 * 33], s[3 * 33]); o.z = pk2(s[4 * 33], s[5 * 33]); o.w = pk2(s[6 * 33], s[7 * 33]);
        *(v4u*)(d.WT + (size_t)(d.dst_row0 + n) * d.K + d.k0 + 8 * c) = o; }
    }
    LDS_WAIT(); asm volatile("" ::: "memory");
}
__device__ __forceinline__ int src_in(int g) {
    const int tile = g >> 3, gi = g & 7;
    if (tile == 0) return 32 * gi;
    if (tile == 1) return 384 + 32 * gi;
    if (tile == 2) { if (gi < 2) return 256 + 32 * gi; if (gi == 2) return 640; if (gi == 3) return -1; if (gi < 6) return 320 + 32 * (gi - 4); if (gi == 6) return 672; return -1; }
    if (tile <= 10) { const int base = tile <= 6 ? 704 : 1728, i = tile - (tile <= 6 ? 3 : 7), gh = gi & 3; return base + (2 * i + (gh >> 1)) * 128 + (gi >= 4 ? 64 : 0) + 32 * (gh & 1); }
    if (tile <= 14) return 2752 + 256 * (tile - 11) + 32 * gi;
    if (tile <= 22) return (gi < 4 ? 3776 : 5824) + 128 * (tile - 15) + 32 * (gi & 3);
    return 4800 + 256 * (tile - 23) + 32 * gi;
}
__device__ __forceinline__ int src_uq(int g) {
    const int tile = g >> 3, gi = g & 7;
    if (tile < 4) return (2 * tile + (gi >> 2)) * 192 + 32 * (gi & 3);
    return (4 * (tile - 4) + (gi & 3)) * 192 + (gi < 4 ? 128 : 160);
}
__device__ __forceinline__ int src_up(int g) { const int tile = g >> 3, gi = g & 7; return (gi < 4 ? 0 : 1024) + 128 * tile + 32 * (gi & 3); }

struct Args { const float* in[18]; float* out; unsigned char* ws; int ph_lo, ph_hi; };
typedef const __attribute__((address_space(4))) Args* KArgsP;

struct P0E { const float* W; unsigned char* WT; int ldw, src_col0, dst_row0, k0; };
__device__ __forceinline__ void p0e_load(const P0E& d, f32x4 (&v)[8], int lane) {
    const int l8 = lane & 7, r8 = lane >> 3;
#pragma unroll
    for (int i = 0; i < 8; ++i) v[i] = __builtin_nontemporal_load((const f32x4*)(d.W + (size_t)(d.k0 + 8 * i + r8) * d.ldw + d.src_col0 + 4 * l8));
}
__device__ __forceinline__ void p0e_finish(const P0E& d, f32x4 (&v)[8], LAS float* scr, int lane) {
    const int l8 = lane & 7, r8 = lane >> 3;
#pragma unroll
    for (int i = 0; i < 8; ++i) { LAS float* p = scr + (8 * i + r8) * 33 + 4 * l8; p[0] = v[i][0]; p[1] = v[i][1]; p[2] = v[i][2]; p[3] = v[i][3]; }
    LDS_WAIT(); asm volatile("" ::: "memory");
    const int c = lane & 3;
#pragma unroll
    for (int j = 0; j < 2; ++j) { const int n = (lane >> 2) + 16 * j; const LAS float* s = scr + (16 * c) * 33 + n; v4u o;
        o.x = pg8::pack4_fp8(32.f * s[0 * 33], 32.f * s[1 * 33], 32.f * s[2 * 33], 32.f * s[3 * 33]); o.y = pg8::pack4_fp8(32.f * s[4 * 33], 32.f * s[5 * 33], 32.f * s[6 * 33], 32.f * s[7 * 33]);
        o.z = pg8::pack4_fp8(32.f * s[8 * 33], 32.f * s[9 * 33], 32.f * s[10 * 33], 32.f * s[11 * 33]); o.w = pg8::pack4_fp8(32.f * s[12 * 33], 32.f * s[13 * 33], 32.f * s[14 * 33], 32.f * s[15 * 33]);
        __builtin_nontemporal_store(o, (v4u*)(d.WT + (size_t)(d.dst_row0 + n) * 1024 + d.k0 + 16 * c)); }
    LDS_WAIT(); asm volatile("" ::: "memory");
}
constexpr int P0_SMALL_ITEMS = 16 * 216 + 6 * 48 + 4 * 64 + 16 * 32, P0_ALL_ITEMS = P0_SMALL_ITEMS + 32 * 16 * 64 + 32 * 16 * 32;
__device__ __forceinline__ void p0_prologue(Frame& F, KArgsP A, int it_lo, int it_hi, int gw, int NGW, bool do_x) {
    const float* x = A->in[0]; const int* positions = (const int*)A->in[1];
    const float *w_in = A->in[2], *q_norm_g = A->in[3], *w_uq = A->in[4], *kv_norm_g = A->in[5], *w_ukv = A->in[6], *w_o = A->in[7], *w_up = A->in[12], *w_down = A->in[14];
    unsigned char* ws = A->ws;
    LAS float* scr = (LAS float*)(F.lds + RING_OFF + F.wave * 16384);
    constexpr int I_IN = 16 * 216, I_UQ = 6 * 48, I_UKV = 4 * 64, I_O = 16 * 32, I_UP = 32 * 16 * 64, I_DN = 32 * 16 * 32;
    constexpr int NITEMS = I_IN + I_UQ + I_UKV + I_O + I_UP + I_DN;
    auto desc = [&](int it) -> P0Item {
        P0Item d; d.valid = it < it_hi; d.fp8 = false; d.kscale = nullptr; d.W = w_in; d.WT = (bf16*)(ws + WS_WIN); d.ldw = 6848; d.K = 1024; d.src_col0 = 0; d.dst_row0 = 0; d.k0 = 0;
        if (!d.valid) return d;
        int r = it;
        if (r < I_IN) { const int kb = r / 216, g = r % 216, sc = src_in(g); d.valid = sc >= 0; d.src_col0 = sc < 0 ? 0 : sc; d.dst_row0 = 32 * g; d.k0 = 64 * kb; return d; } r -= I_IN;
        if (r < I_UQ) { const int kb = r / 48, g = r % 48; d.W = w_uq; d.WT = (bf16*)(ws + WS_WUQ); d.ldw = 1536; d.K = 384; d.src_col0 = src_uq(g); d.dst_row0 = 32 * g; d.k0 = 64 * kb; d.kscale = q_norm_g; return d; } r -= I_UQ;
        if (r < I_UKV) { const int kb = r / 64, g = r % 64; d.W = w_ukv; d.WT = (bf16*)(ws + WS_WUKV); d.ldw = 2048; d.K = 256; d.src_col0 = 32 * g; d.dst_row0 = 32 * g; d.k0 = 64 * kb; d.kscale = kv_norm_g; return d; } r -= I_UKV;
        if (r < I_O) { const int kb = r / 32, g = r % 32; d.W = w_o; d.WT = (bf16*)(ws + WS_WO); d.ldw = 1024; d.src_col0 = 32 * g; d.dst_row0 = 32 * g; d.k0 = 64 * kb; return d; } r -= I_O;
        if (r < I_UP) { const int e = r / 1024, q = r % 1024, kb = q / 64, g = q % 64;
            d.W = w_up + (size_t)e * 1024 * 2048; d.WT = (bf16*)(ws + WS_WUP + (size_t)e * 2048 * 1024); d.fp8 = true; d.ldw = 2048; d.src_col0 = src_up(g); d.dst_row0 = 32 * g; d.k0 = 64 * kb; return d; } r -= I_UP;
        { const int e = r / 512, q = r % 512, kb = q / 32, g = q % 32;
            d.W = w_down + (size_t)e * 1024 * 1024; d.WT = (bf16*)(ws + WS_WDN + (size_t)e * 1024 * 1024); d.fp8 = true; d.ldw = 1024; d.src_col0 = 32 * g; d.dst_row0 = 32 * g; d.k0 = 64 * kb; return d; }
    };
    static_assert(NITEMS == P0_ALL_ITEMS, "item count");
    { f32x4 v0[8], v1[8], v2[8], v3[8]; const int i0 = it_lo + gw; P0Item d0 = desc(i0), d1 = desc(i0 + NGW), d2 = desc(i0 + 2 * NGW), d3;
      p0_load(d0, v0, F.lane); p0_load(d1, v1, F.lane); p0_load(d2, v2, F.lane);
      for (int it = i0; it < it_hi; it += 4 * NGW) {
          d3 = desc(it + 3 * NGW); p0_load(d3, v3, F.lane); p0_finish(d0, v0, scr, F.lane);
          d0 = desc(it + 4 * NGW); p0_load(d0, v0, F.lane); p0_finish(d1, v1, scr, F.lane);
          d1 = desc(it + 5 * NGW); p0_load(d1, v1, F.lane); p0_finish(d2, v2, scr, F.lane);
          d2 = desc(it + 6 * NGW); p0_load(d2, v2, F.lane); p0_finish(d3, v3, scr, F.lane); } }
    if (!do_x) return;
    bf16* XB = (bf16*)(ws + WS_XB);
    float *cosM = (float*)(ws + WS_COSM), *sinM = (float*)(ws + WS_SINM), *cosR = (float*)(ws + WS_COSR), *sinR = (float*)(ws + WS_SINR);
    const double rfR = exp2(-(double)F.lane * (13.287712379549449 / 63.0)) * 0.15915494309189535, rfM = exp2(-(double)(F.lane & 31) * (13.287712379549449 / 32.0)) * 0.15915494309189535;
    for (int m0 = gw; m0 < T; m0 += 4 * NGW) {
        f32x4 xv[4][4]; int pp[4];
#pragma unroll
        for (int k = 0; k < 4; ++k) { const int mk = m0 + k * NGW < T ? m0 + k * NGW : m0; const f32x4* xr = (const f32x4*)(x + (size_t)mk * DM) + F.lane; pp[k] = positions[mk];
#pragma unroll
            for (int j = 0; j < 4; ++j) xv[k][j] = __builtin_nontemporal_load(xr + 64 * j); }
#pragma unroll
        for (int k = 0; k < 4; ++k) { const int m = m0 + k * NGW; if (m < T) {
        unsigned long long* o8 = (unsigned long long*)(XB + (size_t)m * DM) + F.lane;
#pragma unroll
        for (int j = 0; j < 4; ++j) { const f32x4 v = xv[k][j]; o8[64 * j] = (unsigned long long)pk2(v.x, v.y) | ((unsigned long long)pk2(v.z, v.w) << 32); }
        const double pos = (double)pp[k];
        { const int i = F.lane;
          const double rev = pos * rfR; const float fr = (float)(rev - rint(rev));
          cosR[(size_t)m * 64 + i] = __builtin_amdgcn_cosf(fr); sinR[(size_t)m * 64 + i] = __builtin_amdgcn_sinf(fr); }
        if (F.lane < 32) { const int i = F.lane;
          const double rev = pos * rfM; const float fr = (float)(rev - rint(rev));
          cosM[(size_t)m * 32 + i] = __builtin_amdgcn_cosf(fr); sinM[(size_t)m * 32 + i] = __builtin_amdgcn_sinf(fr); }
        } }
    }
}

template <int NB>
__device__ __forceinline__ void p0e_block(Frame& F, KArgsP A, int it0, int stride, int it_hi) {
    const float *w_up = A->in[12], *w_down = A->in[14]; unsigned char* ws = A->ws;
    LAS float* scr = (LAS float*)(F.lds + RING_OFF + F.wave * 16384);
    constexpr int UP_END = P0_SMALL_ITEMS + 32 * 16 * 64, DEPTH = NB < 5 ? NB : 5;
    auto desc = [&](int it) -> P0E { P0E d; it = it < it_hi ? it : it_hi - 1;
        if (it < UP_END) { const int r = it - P0_SMALL_ITEMS, e = r >> 10, q = r & 1023, kb = q >> 6, g = q & 63;
            d.W = w_up + (size_t)e * 1024 * 2048; d.WT = ws + WS_WUP + (size_t)e * 2048 * 1024; d.ldw = 2048; d.src_col0 = src_up(g); d.dst_row0 = 32 * g; d.k0 = 64 * kb; }
        else { const int r = it - UP_END, e = r >> 9, q = r & 511, kb = q >> 5, g = q & 31;
            d.W = w_down + (size_t)e * 1024 * 1024; d.WT = ws + WS_WDN + (size_t)e * 1024 * 1024; d.ldw = 1024; d.src_col0 = 32 * g; d.dst_row0 = 32 * g; d.k0 = 64 * kb; }
        return d; };
    P0E d[DEPTH]; f32x4 v[DEPTH][8];
#pragma unroll
    for (int k = 0; k < DEPTH; ++k) { d[k] = desc(it0 + k * stride); p0e_load(d[k], v[k], F.lane); }
#pragma unroll
    for (int k = 0; k < NB; ++k) { const int sl = k % DEPTH; p0e_finish(d[sl], v[sl], scr, F.lane);
        if (k + DEPTH < NB) { d[sl] = desc(it0 + (k + DEPTH) * stride); p0e_load(d[sl], v[sl], F.lane); } }
}

__device__ __forceinline__ void p6_reduce16(const float (&p)[16], int lane, float& out) {
    float q8[8], q4[4], q2[2];
    { const bool up = (lane & 32) != 0;
#pragma unroll
      for (int k = 0; k < 8; ++k) { const float snd = up ? p[k] : p[k + 8], keep = up ? p[k + 8] : p[k]; q8[k] = keep + __shfl_xor(snd, 32); } }
    { const bool up = (lane & 16) != 0;
#pragma unroll
      for (int k = 0; k < 4; ++k) { const float snd = up ? q8[k] : q8[k + 4], keep = up ? q8[k + 4] : q8[k]; q4[k] = keep + __shfl_xor(snd, 16); } }
    { const bool up = (lane & 8) != 0;
#pragma unroll
      for (int k = 0; k < 2; ++k) { const float snd = up ? q4[k] : q4[k + 2], keep = up ? q4[k + 2] : q4[k]; q2[k] = keep + __shfl_xor(snd, 8); } }
    { const bool up = (lane & 4) != 0; const float snd = up ? q2[0] : q2[1], keep = up ? q2[1] : q2[0]; out = keep + __shfl_xor(snd, 4); }
    out += __shfl_xor(out, 2); out += __shfl_xor(out, 1);
}
__device__ __forceinline__ void p6_ln1_router(Frame& F, KArgsP A, bool dummy, const unsigned* y_cnt = nullptr) {
    unsigned char* ws = A->ws;
    const float *ln_g = A->in[8], *ln_b = A->in[9], *w_router = A->in[10], *b_router = A->in[11];
    const bf16* Y = (const bf16*)(ws + WS_Y); bf16* H1B = (bf16*)(ws + WS_H1B); unsigned char* H1Q = ws + WS_H1Q;
    int* ROWE = (int*)(ws + WS_H1);
    int* TOPI = (int*)(ws + WS_TOPI); float* GATE = (float*)(ws + WS_GATE); int* RANK = (int*)(ws + (dummy ? WS_XS : WS_RANK)); unsigned* CNT = F.ctl + (dummy ? CW_CNT + 128 : CW_CNT);
    constexpr int AROW = 1032;
    LAS unsigned short* AH = (LAS unsigned short*)(F.lds); LAS unsigned short* AL = AH + 16 * AROW;
    LAS float* PART = (LAS float*)(F.lds + 2 * 16 * AROW * 2);
    LAS int* le = (LAS int*)(F.lds + RT_LIST_OFF);
    LAS float* wsc = (LAS float*)(F.lds + RT_SCR_OFF) + F.wave * 96;
    const int lane0 = F.lane;
    pg8::bf16x8 Whi[4][2], Wlo[4][2];
    { const int fr = lane0 & 15, fq = lane0 >> 4;
#pragma unroll
      for (int ks = 0; ks < 4; ++ks)
#pragma unroll
          for (int eb = 0; eb < 2; ++eb) { float wv[8];
#pragma unroll
              for (int j = 0; j < 8; ++j) wv[j] = w_router[(size_t)(128 * F.wave + 32 * ks + 8 * fq + j) * 32 + 16 * eb + fr];
#pragma unroll
              for (int j = 0; j < 8; ++j) { const unsigned short hi = f2bf(wv[j]); const float lo = wv[j] - __uint_as_float((unsigned)hi << 16); Whi[ks][eb][j] = (short)hi; Wlo[ks][eb][j] = (short)f2bf(lo); } } }
    const float ebl = b_router[lane0 & 31];
    __syncthreads();
    for (int unit = F.vcu; unit < T / 64; unit += F.G) {
        const int t0 = unit * 64;
        if (y_cnt) {
            if (F.tid == 0) { int sp = 0; while (__hip_atomic_load(y_cnt + (unit >> 2), __ATOMIC_RELAXED, __HIP_MEMORY_SCOPE_AGENT) < 4u) { __builtin_amdgcn_s_sleep(4); if (++sp > (1 << 22)) { __hip_atomic_store(F.ctl + CW_TMO, 0xDEAD0056u, __ATOMIC_RELAXED, __HIP_MEMORY_SCOPE_AGENT); break; } } }
            __syncthreads(); }
#pragma unroll 1
        for (int pr = 0; pr < 4; ++pr) {
            const int tl0 = F.wave + 16 * pr;
            int lane = lane0; asm volatile("" : "+v"(lane));
            float v[2][16];
#pragma unroll
            for (int u = 0; u < 2; ++u)
                { const bf16* yp = Y + (size_t)(t0 + tl0 + 8 * u) * DM + lane;
#pragma unroll
                  for (int i = 0; i < 16; ++i) v[u][i] = __uint_as_float((unsigned)__builtin_nontemporal_load(yp + 64 * i) << 16); }
            float lgv[16], lbv[16];
#pragma unroll
            for (int i = 0; i < 16; ++i) { lgv[i] = ln_g[lane + 64 * i]; lbv[i] = ln_b[lane + 64 * i]; }
            __builtin_amdgcn_sched_barrier(0);
            float s[2] = {0.f, 0.f};
#pragma unroll
            for (int i = 0; i < 16; ++i) { s[0] += v[0][i]; s[1] += v[1][i]; }
            s[0] = pg8::wave_allsum(s[0]); s[1] = pg8::wave_allsum(s[1]);
            const float mean0 = s[0] * (1.0f / DM), mean1 = s[1] * (1.0f / DM); float q0 = 0.f, q1 = 0.f;
#pragma unroll
            for (int i = 0; i < 16; ++i) { v[0][i] -= mean0; v[1][i] -= mean1; q0 += v[0][i] * v[0][i]; q1 += v[1][i] * v[1][i]; }
            q0 = pg8::wave_allsum(q0); q1 = pg8::wave_allsum(q1);
            const float rstd0 = 1.0f / sqrtf(q0 * (1.0f / DM) + LN_EPS), rstd1 = 1.0f / sqrtf(q1 * (1.0f / DM) + LN_EPS);
            const size_t ta = (size_t)(t0 + tl0) * DM + lane, tb = ta + 8 * DM;
            bf16* hba = H1B + ta; bf16* hbb = H1B + tb;
#pragma unroll
            for (int i = 0; i < 16; ++i) { const float gg = lgv[i], bb = lbv[i]; v[0][i] = v[0][i] * rstd0 * gg + bb; v[1][i] = v[1][i] * rstd1 * gg + bb; }
#pragma unroll
            for (int i = 0; i < 16; ++i) { hba[64 * i] = (bf16)f2bf(v[0][i]); hbb[64 * i] = (bf16)f2bf(v[1][i]); }
#pragma unroll
            for (int u = 0; u < 2; ++u) { LAS unsigned short* ah = AH + (F.wave + 8 * u) * AROW + lane; LAS unsigned short* al = AL + (F.wave + 8 * u) * AROW + lane;
#pragma unroll
                for (int i = 0; i < 16; ++i) { const unsigned short hi = f2bf(v[u][i]); ah[64 * i] = hi; al[64 * i] = f2bf(v[u][i] - __uint_as_float((unsigned)hi << 16)); } }
            __syncthreads();
            { const int fr = lane & 15, fq = lane >> 4; f32x4 lacc[2] = {{0.f, 0.f, 0.f, 0.f}, {0.f, 0.f, 0.f, 0.f}};
              pg8::bf16x8 ahf[4], alf[4];
#pragma unroll
              for (int ks = 0; ks < 4; ++ks) { const int o = fr * AROW + 128 * F.wave + 32 * ks + 8 * fq; ahf[ks] = *(const LAS pg8::bf16x8*)(AH + o); alf[ks] = *(const LAS pg8::bf16x8*)(AL + o); }
#pragma unroll
              for (int ks = 0; ks < 4; ++ks)
#pragma unroll
                  for (int eb = 0; eb < 2; ++eb) {
                      lacc[eb] = __builtin_amdgcn_mfma_f32_16x16x32_bf16(ahf[ks], Whi[ks][eb], lacc[eb], 0, 0, 0);
                      lacc[eb] = __builtin_amdgcn_mfma_f32_16x16x32_bf16(ahf[ks], Wlo[ks][eb], lacc[eb], 0, 0, 0);
                      lacc[eb] = __builtin_amdgcn_mfma_f32_16x16x32_bf16(alf[ks], Whi[ks][eb], lacc[eb], 0, 0, 0); }
#pragma unroll
              for (int u = 0; u < 2; ++u) { const LAS unsigned short* ar = AH + (F.wave + 8 * u) * AROW + 16 * lane; const pg8::bf16x8 c0 = *(const LAS pg8::bf16x8*)ar, c1 = *(const LAS pg8::bf16x8*)(ar + 8);
#define P6_BF(x) __uint_as_float((unsigned)(unsigned short)(x) << 16)
                  v4u o; o.x = pg8::pack4_fp8(P6_BF(c0[0]), P6_BF(c0[1]), P6_BF(c0[2]), P6_BF(c0[3])); o.y = pg8::pack4_fp8(P6_BF(c0[4]), P6_BF(c0[5]), P6_BF(c0[6]), P6_BF(c0[7]));
                  o.z = pg8::pack4_fp8(P6_BF(c1[0]), P6_BF(c1[1]), P6_BF(c1[2]), P6_BF(c1[3])); o.w = pg8::pack4_fp8(P6_BF(c1[4]), P6_BF(c1[5]), P6_BF(c1[6]), P6_BF(c1[7]));
#undef P6_BF
                  ((v4u*)(H1Q + (size_t)(t0 + tl0 + 8 * u) * DM))[lane] = o; }
              LAS float* pw = PART + F.wave * 512;
#pragma unroll
              for (int eb = 0; eb < 2; ++eb)
#pragma unroll
                  for (int r = 0; r < 4; ++r) pw[(4 * fq + r) * 32 + 16 * eb + fr] = lacc[eb][r]; }
            __syncthreads();
            { const int u = lane >> 5, e = lane & 31; float lg = ebl;
#pragma unroll
              for (int w8 = 0; w8 < 8; ++w8) lg += PART[w8 * 512 + (F.wave + 8 * u) * 32 + e];
              wsc[48 * u + e] = lg; }
            LDS_WAIT(); asm volatile("" ::: "memory");
            { const int e = lane & 31; const LAS float* wt = wsc + 48 * (lane >> 5); const float mine = wt[e]; int rk = 0;
#pragma unroll
              for (int q = 0; q < 8; ++q) { const f32x4 a = *(const LAS f32x4*)(wt + 4 * q);
#pragma unroll
                  for (int j = 0; j < 4; ++j) rk += (int)(a[j] > mine) | ((int)(a[j] == mine) & (int)(4 * q + j < e)); }
              LDS_WAIT(); asm volatile("" ::: "memory");
              if (rk < 4) { ((LAS float*)wt)[32 + rk] = mine; ((LAS int*)wt)[36 + rk] = e; } }
            LDS_WAIT(); asm volatile("" ::: "memory");
            if (lane < 2) { const LAS float* w = wsc + 48 * lane; const f32x4 tv = *(const LAS f32x4*)(w + 32); const i32x4 ti = *(const LAS i32x4*)(w + 36);
                const float e1 = __expf(tv[1] - tv[0]), e2 = __expf(tv[2] - tv[0]), e3 = __expf(tv[3] - tv[0]), inv = 1.0f / (1.0f + e1 + e2 + e3);
                const int tl = tl0 + 8 * lane; const size_t t = (size_t)(t0 + tl);
                *(i32x4*)(TOPI + t * 4) = ti; *(float4*)(GATE + t * 4) = make_float4(inv, e1 * inv, e2 * inv, e3 * inv);
                *(LAS i32x4*)(le + tl * 4) = ti; }
            LDS_WAIT(); asm volatile("" ::: "memory");
        }
        __syncthreads();
        { LAS int* cw = (LAS int*)(F.lds + RT_SCR_OFF);
          int my_e = -1, my_r = 0;
          if (F.tid < 256) { my_e = le[F.tid];
              for (int e = 0; e < 32; ++e) { const unsigned long long m = __ballot(my_e == e);
                  if (my_e == e) my_r = __popcll(m & ((1ull << F.lane) - 1ull));
                  if (F.lane == e) cw[F.wave * 32 + e] = __popcll(m); } }
          __syncthreads();
          if (F.tid < 32) { const int c0 = cw[F.tid], c1 = cw[32 + F.tid], c2 = cw[64 + F.tid], c3 = cw[96 + F.tid], tot = c0 + c1 + c2 + c3;
              int base = 0; if (tot) base = (int)atomicAdd(CNT + F.tid, (unsigned)tot);
              cw[128 + F.tid] = base; }
          __syncthreads();
          if (F.tid < 256) { int r = cw[128 + my_e] + my_r;
              for (int w = 0; w < F.wave; ++w) r += cw[w * 32 + my_e];
              RANK[(size_t)t0 * 4 + F.tid] = r; if (!dummy) ROWE[(size_t)my_e * WS_ROWE_STRIDE + r] = t0 + (F.tid >> 2); }
          __syncthreads(); }
    }
}
constexpr int LAY_PST = 0, LAY_CNT = 32, LAY_T0 = 64, LAY_TE = 96, LAY_NMT = 384;
__device__ __forceinline__ int moe_layout(Frame& F, LAS int* lay) {
    __syncthreads();
    if (F.wave == 0) {
        const int e = F.lane & 31, cnt = (int)__hip_atomic_load(F.ctl + CW_CNT + e, RLX_AGENT), tl = (cnt + 255) >> 8; int inc = tl;
#pragma unroll
        for (int o = 1; o < 32; o <<= 1) { const int v = __shfl_up(inc, o); if (e >= o) inc += v; }
        const int excl = inc - tl;
        if (F.lane < 32) { lay[LAY_PST + e] = excl * 256; lay[LAY_CNT + e] = cnt; lay[LAY_T0 + e] = excl;
            for (int i = 0; i < tl; ++i) lay[LAY_TE + excl + i] = e;
            if (e == 31) lay[LAY_NMT] = inc; } }
    __syncthreads();
    return lay[LAY_NMT];
}
__device__ __forceinline__ void p10_combine_ln2(Frame& F, KArgsP A) {
    unsigned char* ws = A->ws;
    const float *ln_g = A->in[16], *ln_b = A->in[17];
    const bf16* H1B = (const bf16*)(ws + WS_H1B); const float* GATE = (const float*)(ws + WS_GATE); const int* TOPI = (const int*)(ws + WS_TOPI); const int* RANK = (const int*)(ws + WS_RANK); const unsigned char* YS = ws + WS_YS;
    LAS int* lay = (LAS int*)(F.lds + RT_LIST_OFF); moe_layout(F, lay);
    const int gw = F.vcu * NWAVES + F.wave, NGW = F.G * NWAVES;
    f32x4 lg[4], lb[4];
#pragma unroll
    for (int j = 0; j < 4; ++j) { lg[j] = ((const f32x4*)ln_g)[F.lane + 64 * j]; lb[j] = ((const f32x4*)ln_b)[F.lane + 64 * j]; }
    if (gw >= T) return;
#define P10_DATA(N, tt) do { const int sk_[4] = {lay[ti##N.x] + rk##N.x, lay[ti##N.y] + rk##N.y, lay[ti##N.z] + rk##N.z, lay[ti##N.w] + rk##N.w}; gt##N = *(const float4*)(GATE + (size_t)(tt) * 4); _Pragma("unroll") for (int j = 0; j < 4; ++j) { hh##N[j] = __builtin_nontemporal_load((const v2u*)(H1B + (size_t)(tt) * DM) + F.lane + 64 * j); \
        _Pragma("unroll") for (int k = 0; k < 4; ++k) y##N[j][k] = __builtin_nontemporal_load((const unsigned*)(YS + (size_t)sk_[k] * DM) + F.lane + 64 * j); } } while (0)
#define P10_STEP(tt, C, N) do { const int t0_ = (tt), t1_ = t0_ + NGW < T ? t0_ + NGW : t0_, t2_ = t0_ + 2 * NGW < T ? t0_ + 2 * NGW : t0_; \
        ti##C = *(const int4*)(TOPI + (size_t)t2_ * 4); rk##C = *(const int4*)(RANK + (size_t)t2_ * 4); P10_DATA(N, t1_); __builtin_amdgcn_sched_barrier(0);     \
        const float gk[4] = {gt##C.x, gt##C.y, gt##C.z, gt##C.w}; f32x4 v[4]; float s = 0.f; \
        _Pragma("unroll") for (int j = 0; j < 4; ++j) { { const v2u hh = hh##C[j]; \
              v[j].x = DN_ALPHA * __uint_as_float(hh.x << 16); v[j].y = DN_ALPHA * __uint_as_float(hh.x & 0xffff0000u); v[j].z = DN_ALPHA * __uint_as_float(hh.y << 16); v[j].w = DN_ALPHA * __uint_as_float(hh.y & 0xffff0000u); } \
            _Pragma("unroll") for (int k = 0; k < 4; ++k) { const int y = (int)y##C[j][k]; const float gq = gk[k] * 0.0625f;     \
                v[j].x += gq * __builtin_amdgcn_cvt_f32_fp8(y, 0); v[j].y += gq * __builtin_amdgcn_cvt_f32_fp8(y, 1); v[j].z += gq * __builtin_amdgcn_cvt_f32_fp8(y, 2); v[j].w += gq * __builtin_amdgcn_cvt_f32_fp8(y, 3); } \
            s += (v[j].x + v[j].y) + (v[j].z + v[j].w); } \
        const float mean = wave_sum(s) * (1.0f / DM); float s2 = 0.f; \
        _Pragma("unroll") for (int j = 0; j < 4; ++j) { v[j] = v[j] - mean; s2 += (v[j].x * v[j].x + v[j].y * v[j].y) + (v[j].z * v[j].z + v[j].w * v[j].w); } \
        const float rstd = 1.0f / sqrtf(wave_sum(s2) * (1.0f / DM) + LN_EPS); \
        _Pragma("unroll") for (int j = 0; j < 4; ++j) { v[j] = v[j] * rstd * lg[j] + lb[j]; __builtin_nontemporal_store(v[j], (f32x4*)(A->out + (size_t)t0_ * DM) + F.lane + 64 * j); } __builtin_amdgcn_sched_barrier(0); } while (0)
    float4 gt0, gt1; int4 ti0, ti1, rk0, rk1; v2u hh0[4], hh1[4]; unsigned y0[4][4], y1[4][4];
    ti0 = *(const int4*)(TOPI + (size_t)gw * 4); rk0 = *(const int4*)(RANK + (size_t)gw * 4); { const int t1 = gw + NGW < T ? gw + NGW : gw; ti1 = *(const int4*)(TOPI + (size_t)t1 * 4); rk1 = *(const int4*)(RANK + (size_t)t1 * 4); }
    P10_DATA(0, gw);
    for (int t = gw; t < T; t += 2 * NGW) {
        P10_STEP(t, 0, 1);
        P10_STEP(t + NGW < T ? t + NGW : t, 1, 0);
    }
#undef P10_STEP
#undef P10_DATA
}

#ifndef DBG_SUB
#define DBG_SUB 2
#endif
#ifndef DBG_STAGE
#define DBG_STAGE 0
#endif
#if DBG_STAGE == 2
#define PH_MASK 0x403
#elif DBG_STAGE == 3
#define PH_MASK 0x407
#elif DBG_STAGE == 4
#define PH_MASK 0x41f
#elif DBG_STAGE == 6
#define PH_MASK 0x40f
#elif DBG_STAGE == 7
#define PH_MASK 0x407
#elif DBG_STAGE == 8
#define PH_MASK 0x407
#endif
__device__ __forceinline__ void dbg_copy_out(Frame& F, KArgsP A) {
    unsigned char* ws = A->ws; const int gw = F.vcu * NWAVES + F.wave, NGW = F.G * NWAVES;
    for (int t = gw; t < T; t += NGW) {
#pragma unroll
        for (int j = 0; j < 4; ++j) { f32x4 v;
#if DBG_STAGE == 1
            v = ((const f32x4*)((const float*)(ws + WS_Y) + (size_t)t * DM))[F.lane + 64 * j];
#elif DBG_STAGE == 2
            { const v2u y = ((const v2u*)((const bf16*)(ws + WS_RQ) + (size_t)t * DM))[F.lane + 64 * j]; v.x = __uint_as_float(y.x << 16); v.y = __uint_as_float(y.x & 0xffff0000u); v.z = __uint_as_float(y.y << 16); v.w = __uint_as_float(y.y & 0xffff0000u); }
#elif DBG_STAGE == 3
            { const v2u y = ((const v2u*)((const bf16*)(ws + WS_KN) + (size_t)t * DM))[F.lane + 64 * j]; v.x = __uint_as_float(y.x << 16); v.y = __uint_as_float(y.x & 0xffff0000u); v.z = __uint_as_float(y.y << 16); v.w = __uint_as_float(y.y & 0xffff0000u); }
#elif DBG_STAGE == 4 || DBG_STAGE == 6
            { const v2u y = ((const v2u*)((const bf16*)(ws + WS_MIX) + (size_t)t * DM))[F.lane + 64 * j]; v.x = __uint_as_float(y.x << 16); v.y = __uint_as_float(y.x & 0xffff0000u); v.z = __uint_as_float(y.y << 16); v.w = __uint_as_float(y.y & 0xffff0000u); }
#elif DBG_STAGE == 7
            { const v2u y = ((const v2u*)((const bf16*)(ws + WS_QB) + (size_t)t * 1536))[F.lane + 64 * j]; v.x = __uint_as_float(y.x << 16); v.y = __uint_as_float(y.x & 0xffff0000u); v.z = __uint_as_float(y.y << 16); v.w = __uint_as_float(y.y & 0xffff0000u); }
#elif DBG_STAGE == 8
            { const int c4 = F.lane + 64 * j; const bf16* src = c4 < 16 ? (const bf16*)(ws + WS_KR) + (size_t)t * 64 + 4 * c4 : (c4 < 128 ? (const bf16*)(ws + WS_VB) : (const bf16*)(ws + WS_GM)) + (size_t)t * DM + 4 * c4;
              v2u y = *(const v2u*)src; if ((c4 < 16 ? 0 : (c4 < 128 ? 1 : 2)) != DBG_SUB) y = (v2u){0u, 0u}; v.x = __uint_as_float(y.x << 16); v.y = __uint_as_float(y.x & 0xffff0000u); v.z = __uint_as_float(y.y << 16); v.w = __uint_as_float(y.y & 0xffff0000u); }
#elif DBG_STAGE == 5
            v = ((const f32x4*)((const float*)(ws + WS_H1) + (size_t)t * DM))[F.lane + 64 * j];
#else
            v = (f32x4){0.f, 0.f, 0.f, 0.f};
#endif
            ((f32x4*)(A->out + (size_t)t * DM))[F.lane + 64 * j] = v; }
    }
}

__global__ void __launch_bounds__(NWAVES * 64, 2) mk_fwd(Args args) {
    extern __shared__ __attribute__((aligned(16))) unsigned char lds[];
    typedef const __attribute__((address_space(4))) Args* KArgs;
#define PHASE_FRAME() Frame F; { int t_ = threadIdx.x; asm volatile("" : "+v"(t_)); F.lds = (LAS unsigned char*)lds; F.MISC = (volatile LAS unsigned*)(F.lds + MISC_OFF); F.tid = t_; F.lane = t_ & 63; \
        F.wave = __builtin_amdgcn_readfirstlane(t_ >> 6); F.G = gridDim.x; const int bx_ = blockIdx.x; F.vcu = (F.G % 8 == 0) ? (bx_ % 8) * (F.G / 8) + bx_ / 8 : bx_; } \
    KArgs ap_ = (KArgs)__builtin_amdgcn_kernarg_segment_ptr(); asm volatile("" : "+s"(ap_)); unsigned char* ws = ap_->ws; F.ctl = (unsigned*)(ws + WS_CTL); unsigned char* w_ = ws; (void)w_
    LAS unsigned char* lds3 = (LAS unsigned char*)lds;
    { const int t0_ = threadIdx.x; for (int u = t0_; u < (LDS_BYTES - MISC_OFF) / 4; u += NWAVES * 64) ((LAS unsigned*)(lds3 + MISC_OFF))[u] = 0u; }
    __syncthreads();
    unsigned* ctl0 = (unsigned*)(args.ws + WS_CTL);
    XcdBarrier bar; bar.bar = ctl0 + CW_BAR; bar.x = 0; bar.st = nullptr;
    if (!MK_PER_PHASE) bar = xcd_barrier_post(ctl0 + CW_BAR, (volatile LAS unsigned*)(lds3 + MISC_OFF) + 8);
#define GRID_BAR() do { if (MK_PER_PHASE) { if (threadIdx.x == 0) __hip_atomic_store(bar.bar - CW_BAR + CW_TMO, 0xBADBA0u, RLX_AGENT); } else { xcd_barrier(bar); } } while (0)
    const int lo = args.ph_lo, hi = args.ph_hi;
#ifndef PH_MASK
#define PH_MASK 0x7ff
#endif
#define IN(k) (((PH_MASK >> (k)) & 1) && lo <= (k) && (k) < hi)
#define BOTH(k) (IN(k) && IN((k) + 1))
#ifndef P4_RET_FIRST
#define P4_RET_FIRST(bh) true
#endif
#ifndef DUP_P0
#define DUP_P0 0
#endif
#ifndef DUP_P1
#define DUP_P1 0
#endif
#ifndef DUP_P2
#define DUP_P2 0
#endif
#ifndef DUP_P3
#define DUP_P3 0
#endif
#ifndef ATT_PROBE_VAR
#define ATT_PROBE_VAR 0
#endif
#ifndef DUP_P4
#define DUP_P4 0
#endif
#ifndef DUP_P5
#define DUP_P5 0
#endif
#ifndef DUP_P6
#define DUP_P6 0
#endif
#ifndef DUP_P7
#define DUP_P7 0
#endif
#ifndef DUP_P8
#define DUP_P8 0
#endif
#ifndef DUP_P9
#define DUP_P9 0
#endif
#ifndef DUP_P10
#define DUP_P10 0
#endif
#define PHASE_IF_0(k) if (IN(k))
#define PHASE_IF_1(k) _Pragma("unroll") for (int rep_ = 0; rep_ < 2; ++rep_) if (IN(k))
#define PHASE_CAT(a, b) a##b
#define PHASE_SEL(d) PHASE_CAT(PHASE_IF_, d)
#define PHASE_IF(k) PHASE_SEL(DUP_P##k)(k)
#if DUP_P4
#define PROBE_FIRST_4 (rep_ == 0)
#else
#define PROBE_FIRST_4 false
#endif
#if DUP_P6
#define PROBE_FIRST_6 (rep_ == 0)
#else
#define PROBE_FIRST_6 false
#endif
    typedef pg8::bf16_t b16;
#define WSP(T_, off) ((T_*)(w_ + (off)))
#define PHASE_WS() PHASE_FRAME()

    bool rt_counted = false;
    bool y_counted = false;
#define NBG_OF(G_) ((G_) == 256 && !MK_PER_PHASE ? 32 : 0)
#define P0_DEFER1 (64 * NWAVES * 10)
#define P0_DEFER2 (128 * NWAVES * 4)
#define P0_DEFER3 8192
#define P0_BG 19000
    PHASE_IF(0) { { PHASE_FRAME(); if (F.tid == 0) { const unsigned xcc = (unsigned)__builtin_amdgcn_s_getreg(20 | (3 << 11)) & 15u;
            __hip_atomic_fetch_or(F.ctl + CW_XMAP + ((int)blockIdx.x & 7), 1u << xcc, __ATOMIC_RELAXED, __HIP_MEMORY_SCOPE_AGENT); }
        p0_prologue(F, ap_, 0, NBG_OF(F.G) ? P0_ALL_ITEMS - P0_DEFER2 - P0_DEFER3 - P0_BG - P0_DEFER1 : P0_ALL_ITEMS, F.vcu * NWAVES + F.wave, F.G * NWAVES, true); } __syncthreads(); if (BOTH(0)) GRID_BAR(); }

    PHASE_IF(1) {
        PHASE_WS();
        const int nbg = NBG_OF(F.G), nmain = F.G - nbg;
        if ((int)blockIdx.x >= nmain) { const int hi = P0_ALL_ITEMS - P0_DEFER2 - P0_DEFER3, ngw = nbg * NWAVES;
            for (int base = hi - P0_BG + ((int)blockIdx.x - nmain) * NWAVES + F.wave; base < hi; base += 10 * ngw) p0e_block<10>(F, ap_, base, ngw, hi);
            __syncthreads(); } else {
        pg8::Gemm g{WSP(b16, WS_XB), WSP(b16, WS_WIN), T, NP1, DM}; pg8::StaticOrder S; S.init(T, NP1, nmain, (int)blockIdx.x);
        pg8::EpiProj E{WSP(b16, WS_CQ), WSP(b16, WS_CKV), WSP(b16, WS_KR), WSP(b16, WS_RQ), WSP(b16, WS_RK), WSP(b16, WS_RV), WSP(b16, WS_GR), WSP(b16, WS_GM),
                       WSP(float, WS_SSQQ), WSP(float, WS_SSQKV), WSP(float, WS_COSM), WSP(float, WS_SINM), WSP(float, WS_COSR), WSP(float, WS_SINR)};
        pg8::gemm_phase<pg8::EpiProj, pg8::StaticOrder, true, true>(F.lds + RING_OFF, g, S, E);
          if (nbg && (int)blockIdx.x >= 160) { __syncthreads();
              const int hi1 = P0_ALL_ITEMS - P0_DEFER2 - P0_DEFER3 - P0_BG; p0e_block<P0_DEFER1 / (64 * NWAVES)>(F, ap_, hi1 - P0_DEFER1 + ((int)blockIdx.x - 160) * NWAVES + F.wave, 64 * NWAVES, hi1); } }
        if (BOTH(1)) GRID_BAR();
    }
    PHASE_IF(2) {
        PHASE_WS();
        { pg8::Gemm g{WSP(b16, WS_CQ), WSP(b16, WS_WUQ), T, 1536, 384}; pg8::StaticOrder S; S.init(T, 1536, F.G, (int)blockIdx.x);
          pg8::EpiQ E{{WSP(b16, WS_QB), WSP(float, WS_SSQQ)}, {WSP(b16, WS_QB), WSP(float, WS_SSQQ), WSP(float, WS_COSM), WSP(float, WS_SINM)}};
          pg8::gemm_phase<pg8::EpiQ, pg8::StaticOrder, true, true>(F.lds + RING_OFF, g, S, E); }
        { pg8::Gemm g{WSP(b16, WS_CKV), WSP(b16, WS_WUKV), T, 2048, 256}; pg8::StaticOrder S; S.init(T, 2048, F.G, (int)blockIdx.x);
          pg8::EpiKV E{WSP(b16, WS_KN), WSP(b16, WS_VB), WSP(float, WS_SSQKV)};
          pg8::gemm_phase<pg8::EpiKV, pg8::StaticOrder, true, true>(F.lds + RING_OFF, g, S, E); }
        ret::u_phase(WSP(b16, WS_RK), WSP(b16, WS_RV), WSP(b16, WS_UT), F.vcu, F.G, (LAS char*)F.lds);
        if (F.G == 256 && !MK_PER_PHASE && (int)blockIdx.x >= 128) { __syncthreads(); p0e_block<P0_DEFER2 / (128 * NWAVES)>(F, ap_, P0_ALL_ITEMS - P0_DEFER2 - P0_DEFER3 + ((int)blockIdx.x - 128) * NWAVES + F.wave, 128 * NWAVES, P0_ALL_ITEMS - P0_DEFER3); }
        if (BOTH(2)) GRID_BAR();
    }
    PHASE_IF(3) {
        PHASE_WS();
        ret::scan_all(WSP(b16, WS_UT), WSP(b16, WS_RT), F.vcu * (NWAVES * 64) + F.tid, F.G * NWAVES * 64);
        rt_counted = BOTH(3) && !MK_PER_PHASE && !DUP_P3 && !DUP_P4 && F.G == 256;
        for (int i = 0; i < 8; ++i) { const unsigned m = __hip_atomic_load(F.ctl + CW_XMAP + i, RLX_AGENT); rt_counted = rt_counted && __builtin_popcount(m) == 1; }
        if (rt_counted) { asm volatile("s_waitcnt vmcnt(0)" ::: "memory"); __syncthreads();
            if (F.tid == 0) __hip_atomic_fetch_add(F.ctl + CW_C3 + (F.vcu >> 3), 1u, __ATOMIC_RELAXED, __HIP_MEMORY_SCOPE_AGENT); }
        else if (BOTH(3)) GRID_BAR();
    }
    PHASE_IF(4) {
        PHASE_WS();
        for (int it = F.vcu; it < 256; it += F.G) {
            if (rt_counted) { if (F.tid == 0) { int sp = 0; while (__hip_atomic_load(F.ctl + CW_C3 + (it >> 3), __ATOMIC_RELAXED, __HIP_MEMORY_SCOPE_AGENT) < 8u) { __builtin_amdgcn_s_sleep(4); if (++sp > (1 << 22)) { __hip_atomic_store(F.ctl + CW_TMO, 0xDEAD0034u, __ATOMIC_RELAXED, __HIP_MEMORY_SCOPE_AGENT); break; } } }
                __syncthreads(); }
            unsigned char* w_ = ws; asm volatile("" : "+s"(w_));
            const att::Tensors X{WSP(b16, WS_QB), WSP(b16, WS_KN), WSP(b16, WS_KR), WSP(b16, WS_VB), WSP(b16, WS_GM), WSP(b16, WS_MIX)};
            const int bh = it >> 3, x = it & 7; const unsigned nl = (unsigned)(2 * x) | ((unsigned)(2 * x + 1) << 8) | ((unsigned)(2 * (15 - x)) << 16) | ((unsigned)(2 * (15 - x) + 1) << 24);
            const int grp = bh % 3; const unsigned nl4 = grp == 1 ? ((nl >> 16) | (nl << 16)) : nl;
#define P4_RET(msk_) ret::out_phase(WSP(b16, WS_RQ), WSP(b16, WS_RK), WSP(b16, WS_RV), WSP(b16, WS_RT), WSP(b16, WS_GR), WSP(b16, WS_MIX), WSP(b16, WS_MIX), bh, nl4, 4, msk_, (LAS char*)F.lds)
            if (grp == 0) {
                P4_RET(0u);
                att::attn_unit<0, true>(X, bh >> 3, bh & 7, 15 - x, (LAS char*)F.lds);
                att::attn_unit<0, true>(X, bh >> 3, bh & 7, x, (LAS char*)F.lds);
            } else if (grp == 1) {
                att::attn_unit<0, false>(X, bh >> 3, bh & 7, 15 - x, (LAS char*)F.lds);
                P4_RET(3u);
                att::attn_unit<0, true>(X, bh >> 3, bh & 7, x, (LAS char*)F.lds);
            } else {
                att::attn_unit<0, false>(X, bh >> 3, bh & 7, 15 - x, (LAS char*)F.lds);
                att::attn_unit<0, false>(X, bh >> 3, bh & 7, x, (LAS char*)F.lds);
                P4_RET(15u);
            }
#undef P4_RET
        }
        if (BOTH(4)) GRID_BAR();
    }
    PHASE_IF(5) {
        PHASE_WS();
        pg8::Gemm g{WSP(b16, WS_MIX), WSP(b16, WS_WO), T, DM, DM}; pg8::StaticOrder S; S.init(T, DM, F.G, (int)blockIdx.x);
        pg8::EpiY E{WSP(b16, WS_XB), WSP(b16, WS_Y), DN_ALPHA};
        pg8::gemm_phase<pg8::EpiY, pg8::StaticOrder, true, true>(F.lds + RING_OFF, g, S, E);
        y_counted = BOTH(5) && !MK_PER_PHASE && !DUP_P5 && !DUP_P6 && F.G == 256;
        for (int i = 0; i < 8; ++i) { const unsigned m = __hip_atomic_load(F.ctl + CW_XMAP + i, RLX_AGENT); y_counted = y_counted && __builtin_popcount(m) == 1; }
        if (y_counted) { if (F.tid == 0) { pg8::Unit uu; for (int i = 0; S.next(i, uu); ++i) __hip_atomic_fetch_add(F.ctl + CW_C5 + uu.pm, 1u, __ATOMIC_RELAXED, __HIP_MEMORY_SCOPE_AGENT); } }
        else if (BOTH(5)) GRID_BAR();
    }
    PHASE_IF(6) { { PHASE_FRAME(); p6_ln1_router(F, ap_, PROBE_FIRST_6, y_counted ? F.ctl + CW_C5 : nullptr); } if (BOTH(6)) GRID_BAR(); }
    PHASE_IF(8) {
        PHASE_WS();
        LAS int* lay = (LAS int*)(F.lds + RT_LIST_OFF); const int nmt = moe_layout(F, lay);
        pg8::Gemm g{WSP(b16, WS_H1Q), WSP(b16, WS_WUP), nmt * 256, 2048, DM / 2};
        pg8::GroupedOrder S; S.init(nmt * 256, 2048, F.G, (int)blockIdx.x); S.tile_e = (const int*)(lay + LAY_TE);
        LAS int* tokl = (LAS int*)(F.lds + RING_BYTES);
        { const int* ROWE = WSP(const int, WS_H1); pg8::Unit uu;
          for (int i = 0; S.next(i, uu); ++i) if (F.tid < 256) { const int e = uu.e, idx = (uu.pm - lay[LAY_T0 + e]) * 256 + F.tid;
              tokl[i * 256 + F.tid] = idx < lay[LAY_CNT + e] ? ROWE[(size_t)e * WS_ROWE_STRIDE + idx] : 0; }
          __syncthreads(); }
        pg8::EpiSwiglu E{WSP(unsigned char, WS_A2), ap_->in[13]};
        pg8::gemm_phase<pg8::EpiSwiglu, pg8::GroupedOrder, true, true, true, true>(F.lds + RING_OFF, g, S, E, tokl);
        if (F.G == 256 && !MK_PER_PHASE) {
            const int r = (nmt * 8) % F.G; const bool idle_only = r != 0 && F.G - r >= 64;
            if (!idle_only || (int)blockIdx.x >= r) { __syncthreads();
                const int nw = idle_only ? F.G - r : F.G, w0 = idle_only ? (int)blockIdx.x - r : (int)blockIdx.x;
                for (int base = P0_ALL_ITEMS - P0_DEFER3 + w0 * NWAVES + F.wave; base < P0_ALL_ITEMS; base += 8 * nw * NWAVES) p0e_block<8>(F, ap_, base, nw * NWAVES, P0_ALL_ITEMS); } }
        if (BOTH(8)) GRID_BAR();
    }
    PHASE_IF(9) {
        PHASE_WS();
        LAS int* lay = (LAS int*)(F.lds + RT_LIST_OFF); const int nmt = moe_layout(F, lay);
        pg8::Gemm g{WSP(b16, WS_A2), WSP(b16, WS_WDN), nmt * 256, DM, DM / 2}; pg8::GroupedOrder S; S.init(nmt * 256, DM, F.G, (int)blockIdx.x); S.tile_e = (const int*)(lay + LAY_TE);
        pg8::EpiDown E{WSP(unsigned char, WS_YS), ap_->in[15]};
        pg8::gemm_phase<pg8::EpiDown, pg8::GroupedOrder, true, true, true>(F.lds + RING_OFF, g, S, E);
        if (BOTH(9)) GRID_BAR();
    }
    PHASE_IF(10) { PHASE_FRAME();
#if DBG_STAGE
        dbg_copy_out(F, ap_);
#else
        p10_combine_ln2(F, ap_);
#endif
    }
#undef IN
#undef BOTH
#undef GRID_BAR
}

extern "C" void kernel_launch(void* const* d_in, const int* in_sizes, int n_in, void* d_out, int out_size, void* d_ws, size_t ws_size, hipStream_t stream) {
    static int grid = 0;
    if (grid == 0) {
        if (n_in != 18 || in_sizes[0] != T * DM || out_size != T * DM || ws_size < WS_END) { fprintf(stderr, "kernel_launch: unexpected shapes (n_in %d, in0 %d, out %d, ws %zu)\n", n_in, n_in > 0 ? in_sizes[0] : -1, out_size, ws_size); grid = -1; return; }
        int dev = 0, cus = 0, per_cu = 0;
        if (hipGetDevice(&dev) != hipSuccess || hipDeviceGetAttribute(&cus, hipDeviceAttributeMultiprocessorCount, dev) != hipSuccess) { grid = -1; return; }
        if (hipFuncSetAttribute((const void*)mk_fwd, hipFuncAttributeMaxDynamicSharedMemorySize, LDS_BYTES) != hipSuccess) { fprintf(stderr, "kernel_launch: hipFuncSetAttribute failed\n"); grid = -1; return; }
        if (hipOccupancyMaxActiveBlocksPerMultiprocessor(&per_cu, (const void*)mk_fwd, NWAVES * 64, LDS_BYTES) != hipSuccess || per_cu < 1) { fprintf(stderr, "kernel_launch: occupancy query reports %d\n", per_cu); }
        (void)hipGetLastError();
        grid = cus;
    }
    if (grid < 0) return;
    if (hipMemsetAsync((char*)d_ws + WS_CTL, 0, CTL_ZERO_BYTES, stream) != hipSuccess) return;
    Args a{};
    for (int i = 0; i < 18; ++i) a.in[i] = (const float*)d_in[i];
    a.out = (float*)d_out; a.ws = (unsigned char*)d_ws;
#if MK_PER_PHASE
    for (int p = 0; p < NPH; ++p) { a.ph_lo = p; a.ph_hi = p + 1; hipLaunchKernelGGL(mk_fwd, dim3(grid), dim3(NWAVES * 64), LDS_BYTES, stream, a); }
#else
    a.ph_lo = 0; a.ph_hi = NPH;
    hipLaunchKernelGGL(mk_fwd, dim3(grid), dim3(NWAVES * 64), LDS_BYTES, stream, a);
#endif
}
```
